# Optimizing an MI355X kernel written in HIP

```python
import jax, jax.numpy as jnp
from jax import lax
import numpy as np

D_MODEL = 1024
BATCH = 4
SEQ = 4096
DEPTH = 4

CHUNK = 64
Q_BLOCK = 128
SC_WIDTH = 512
SC_GROUPS = 8
SC_KERNEL = 3
MLA_HEADS = 8
QK_NOPE = 64
QK_ROPE = 32
V_HEAD = 64
Q_LORA = 256
KV_LORA = 128
MLA_WIDTH = MLA_HEADS * V_HEAD
ROPE_THETA = 10000.0
CONF_WIDTH = D_MODEL
CONF_KERNEL = 31
EVEN_SPLITS = (SC_WIDTH, SC_WIDTH, SC_WIDTH, SC_WIDTH, Q_LORA, KV_LORA, QK_ROPE, MLA_WIDTH)
EVEN_IN = sum(EVEN_SPLITS)
ODD_IN = 3 * CONF_WIDTH
N_EVEN = (DEPTH + 1) // 2
N_ODD = DEPTH // 2
EPS = 1e-6

kernel_name = 'hybrid_chunk_causal_conv_mla_conformer_trunk'


def rms_norm(x, g):
    xf = x.astype(jnp.float32)
    y = xf * lax.rsqrt(jnp.mean(xf * xf, axis=-1, keepdims=True) + EPS)
    return (y * g.astype(jnp.float32)).astype(x.dtype)


def layer_norm(x, g, b):
    xf = x.astype(jnp.float32)
    mu = jnp.mean(xf, axis=-1, keepdims=True)
    var = jnp.mean(jnp.square(xf - mu), axis=-1, keepdims=True)
    y = (xf - mu) * lax.rsqrt(var + EPS)
    return (y * g.astype(jnp.float32) + b.astype(jnp.float32)).astype(x.dtype)


def split_cols(z, sizes):
    idx = np.cumsum(sizes)[:-1].tolist()
    return jnp.split(z, idx, axis=-1)


def causal_depthwise_conv(u, w, b):
    k, ch = w.shape
    y = lax.conv_general_dilated(u, w[:, None, :].astype(u.dtype), window_strides=(1,),
                                 padding=[(k - 1, 0)], dimension_numbers=('NWC', 'WIO', 'NWC'),
                                 feature_group_count=ch)
    return y + b.astype(u.dtype)


def rope_tables(positions):
    inv_freq = 1.0 / (ROPE_THETA ** (jnp.arange(0, QK_ROPE, 2, dtype=jnp.float32) / QK_ROPE))
    ang = positions.astype(jnp.float32)[..., None] * inv_freq
    return jnp.cos(ang), jnp.sin(ang)


def apply_rope(t, cos, sin):
    tf = t.astype(jnp.float32)
    t1, t2 = jnp.split(tf, 2, axis=-1)
    return jnp.concatenate([t1 * cos - t2 * sin, t2 * cos + t1 * sin], axis=-1).astype(t.dtype)


def block_causal_attention(q, k, v):
    b, h, s, dqk = q.shape
    nb = s // Q_BLOCK
    scale = 1.0 / np.sqrt(dqk)
    k_chunk = jnp.arange(s) // CHUNK
    qb = q.reshape(b, h, nb, Q_BLOCK, dqk).transpose(2, 0, 1, 3, 4)

    def one_block(args):
        q_blk, blk = args
        scores = jnp.einsum('bhqd,bhkd->bhqk', q_blk, k, preferred_element_type=jnp.float32) * scale
        q_chunk = (blk * Q_BLOCK + jnp.arange(Q_BLOCK)) // CHUNK
        allowed = k_chunk[None, :] <= q_chunk[:, None]
        scores = jnp.where(allowed, scores, jnp.finfo(jnp.float32).min)
        p = jax.nn.softmax(scores, axis=-1)
        return jnp.einsum('bhqk,bhkd->bhqd', p.astype(v.dtype), v)

    out = lax.map(one_block, (qb, jnp.arange(nb)))
    return out.transpose(1, 0, 3, 2, 4).reshape(b, s, h * v.shape[-1])


def even_mixer(h, cos, sin, w_in, sc_conv_w, sc_conv_b, q_norm_g, kv_norm_g, w_uq, w_ukv, w_out):
    bsz, s, _ = h.shape
    z = h @ w_in
    a_b, a_c, a_x, a_gate, c_q, c_kv, k_rope_raw, b_gate = split_cols(z, EVEN_SPLITS)
    y_a = a_b * causal_depthwise_conv(a_c * a_x, sc_conv_w, sc_conv_b)
    y_a = y_a * jax.nn.silu(a_gate)
    q = (rms_norm(c_q, q_norm_g) @ w_uq).reshape(bsz, s, MLA_HEADS, QK_NOPE + QK_ROPE)
    q_nope, q_rope = q[..., :QK_NOPE], q[..., QK_NOPE:]
    q_rope = apply_rope(q_rope, cos[:, :, None, :], sin[:, :, None, :])
    kv = (rms_norm(c_kv, kv_norm_g) @ w_ukv).reshape(bsz, s, MLA_HEADS, QK_NOPE + V_HEAD)
    k_nope, v = kv[..., :QK_NOPE], kv[..., QK_NOPE:]
    k_rope = apply_rope(k_rope_raw, cos, sin)
    k_rope = jnp.broadcast_to(k_rope[:, :, None, :], (bsz, s, MLA_HEADS, QK_ROPE))
    q_full = jnp.concatenate([q_nope, q_rope], axis=-1).transpose(0, 2, 1, 3)
    k_full = jnp.concatenate([k_nope, k_rope], axis=-1).transpose(0, 2, 1, 3)
    y_b = block_causal_attention(q_full, k_full, v.transpose(0, 2, 1, 3))
    y_b = y_b * jax.nn.silu(b_gate)
    return jnp.concatenate([y_a, y_b], axis=-1) @ w_out


def odd_mixer(h, w_in, conv_w, conv_b, ln_g, ln_b, w_out):
    z = h @ w_in
    val, glu_gate, silu_gate = jnp.split(z, 3, axis=-1)
    u = val * jax.nn.sigmoid(glu_gate)
    u = causal_depthwise_conv(u, conv_w, conv_b)
    u = jax.nn.silu(layer_norm(u, ln_g, ln_b))
    return (u * jax.nn.silu(silu_gate)) @ w_out


def setup_inputs(seed: int = 0) -> dict:
    key = jax.random.key(seed)
    ks = iter(jax.random.split(key, 32))

    def nrm(shape, scale):
        return jax.random.normal(next(ks), shape, jnp.float32) * scale

    d = D_MODEL
    return {
        'x': nrm((BATCH, SEQ, d), 1.0),
        'c': nrm((BATCH, d), 1.0),
        'positions': (jax.random.randint(next(ks), (BATCH, 1), 0, 4096, dtype=jnp.int32)
                      + jnp.arange(SEQ, dtype=jnp.int32)[None, :]),
        'ada_w': nrm((DEPTH, d, 3 * d), 0.5 * d ** -0.5),
        'ada_b': nrm((DEPTH, 3 * d), 0.1),
        'pre_norm_g': 1.0 + nrm((DEPTH, d), 0.05),
        'post_norm_g': 1.0 + nrm((DEPTH, d), 0.05),
        'even_w_in': nrm((N_EVEN, d, EVEN_IN), d ** -0.5),
        'even_sc_conv_w': nrm((N_EVEN, SC_KERNEL, SC_WIDTH), SC_KERNEL ** -0.5),
        'even_sc_conv_b': nrm((N_EVEN, SC_WIDTH), 0.01),
        'even_q_norm_g': 1.0 + nrm((N_EVEN, Q_LORA), 0.05),
        'even_kv_norm_g': 1.0 + nrm((N_EVEN, KV_LORA), 0.05),
        'even_w_uq': nrm((N_EVEN, Q_LORA, MLA_HEADS * (QK_NOPE + QK_ROPE)), Q_LORA ** -0.5),
        'even_w_ukv': nrm((N_EVEN, KV_LORA, MLA_HEADS * (QK_NOPE + V_HEAD)), KV_LORA ** -0.5),
        'even_w_out': nrm((N_EVEN, SC_WIDTH + MLA_WIDTH, d), (SC_WIDTH + MLA_WIDTH) ** -0.5),
        'odd_w_in': nrm((N_ODD, d, ODD_IN), d ** -0.5),
        'odd_conv_w': nrm((N_ODD, CONF_KERNEL, CONF_WIDTH), CONF_KERNEL ** -0.5),
        'odd_conv_b': nrm((N_ODD, CONF_WIDTH), 0.01),
        'odd_ln_g': 1.0 + nrm((N_ODD, CONF_WIDTH), 0.05),
        'odd_ln_b': nrm((N_ODD, CONF_WIDTH), 0.01),
        'odd_w_out': nrm((N_ODD, CONF_WIDTH, d), CONF_WIDTH ** -0.5),
    }


def reference(x, c, positions, ada_w, ada_b, pre_norm_g, post_norm_g,
              even_w_in, even_sc_conv_w, even_sc_conv_b, even_q_norm_g, even_kv_norm_g,
              even_w_uq, even_w_ukv, even_w_out,
              odd_w_in, odd_conv_w, odd_conv_b, odd_ln_g, odd_ln_b, odd_w_out):
    cos, sin = rope_tables(positions)
    c_act = jax.nn.silu(c)
    for layer in range(DEPTH):
        mod = c_act @ ada_w[layer] + ada_b[layer]
        shift, scale, gate = jnp.split(mod, 3, axis=-1)
        h = rms_norm(x, pre_norm_g[layer]) * (1.0 + scale[:, None, :]) + shift[:, None, :]
        i = layer // 2
        if layer % 2 == 0:
            y = even_mixer(h, cos, sin, even_w_in[i], even_sc_conv_w[i], even_sc_conv_b[i],
                           even_q_norm_g[i], even_kv_norm_g[i], even_w_uq[i], even_w_ukv[i],
                           even_w_out[i])
        else:
            y = odd_mixer(h, odd_w_in[i], odd_conv_w[i], odd_conv_b[i], odd_ln_g[i],
                          odd_ln_b[i], odd_w_out[i])
        x = x + gate[:, None, :] * rms_norm(y, post_norm_g[layer])
    return x
```

```cpp
#include <hip/hip_runtime.h>
#include <hip/hip_cooperative_groups.h>
#include <cstdio>
#include <cstdint>
namespace cg = cooperative_groups;

#ifndef MK_ONE_LAUNCH
#define MK_ONE_LAUNCH 1
#endif

namespace pg8 {
#define PG8_LAS __attribute__((address_space(3)))
typedef unsigned short bf16_t;
typedef short bf16x8 __attribute__((ext_vector_type(8)));
typedef float f32x4 __attribute__((ext_vector_type(4)));
typedef unsigned u32x4 __attribute__((ext_vector_type(4)));
constexpr int BM = 256, BK = 64, HALF = 128, HTB = HALF * BK * 2, STAGE_BYTES = 8 * HTB, NXCD = 8, WGM = 8;

__host__ __device__ __forceinline__ int lds_byte(int r, int c) { const int st = (r >> 4) * 2 + (c >> 5), rr = r & 15, cc = c & 31, ob = rr * 64 + cc * 2; return st * 1024 + (ob ^ (((ob >> 9) & 1) << 5)); }
__host__ __device__ __forceinline__ void stage_rc(int b, int& R, int& C) { const int st = b / 1024, sb = b % 1024, swz = sb ^ (((sb >> 9) & 1) << 5); R = (st >> 1) * 16 + swz / 64; C = (st & 1) * 32 + (swz % 64) / 2; }
__host__ __device__ __forceinline__ int perm32(int rho) { const int n = rho >> 4, i = rho & 15; return 8 * (i >> 2) + 4 * n + (i & 3); }

struct Unit { int pm, pn; };
struct Gemm { const bf16_t* A; int lda; const bf16_t* Bt; int ldb; int M, N, K; int wave; };

struct StaticOrder {
    int nM, nN, nwg, G, c;
    __host__ __device__ void init(int M, int N, int G_, int c_) { nM = M / BM; nN = N / BM; nwg = nM * nN; G = G_; c = c_; }
    __host__ __device__ bool next(int i, Unit& u) const {
        const long L = (long)i * G + c; if (L >= nwg) return false;
        int wgid = (int)L; { const int q = nwg / NXCD, r = nwg % NXCD, xcd = wgid % NXCD, off = wgid / NXCD; wgid = (xcd < r ? xcd * (q + 1) : r * (q + 1) + (xcd - r) * q) + off; }
        const int nig = WGM * nN, gid = wgid / nig, fm = gid * WGM, gsz = (nM - fm) < WGM ? (nM - fm) : WGM;
        u.pm = fm + ((wgid % nig) % gsz); u.pn = (wgid % nig) / gsz; return true;
    }
    __device__ __forceinline__ void a_ready(const Unit&) const {}
    __device__ __forceinline__ void done(const Unit&) const {}
};

__device__ __forceinline__ unsigned cvt_pk_bf16(float lo, float hi) { unsigned r; asm volatile("v_cvt_pk_bf16_f32 %0, %1, %2" : "=v"(r) : "v"(lo), "v"(hi)); return r;}

template <class Epi, class Sched, bool ALIGN_EPI = false, bool SP2 = false>
__device__ __forceinline__ void gemm_phase(PG8_LAS unsigned char* lds, const Gemm g, const Sched& S, const Epi& E) {
    int lane; asm volatile("v_mbcnt_lo_u32_b32 %0, -1, 0\n\tv_mbcnt_hi_u32_b32 %0, -1, %0" : "=v"(lane)); int wid = g.wave; asm volatile("" : "+s"(wid)); const int tid = wid * 64 + lane, wr = wid >> 2, wc = wid & 3, fr = lane & 15, fq = lane >> 4;
    const int K = g.K, nt = K / BK;
    unsigned voffA[2], voffB[2];
#pragma unroll
    for (int i = 0; i < 2; ++i) { int R, C; stage_rc(tid * 16 + i * 8192, R, C); const int Rb = Epi::PERM ? ((R & ~31) + perm32(R & 31)) : R;
        voffA[i] = (unsigned)(R * g.lda + C) * 2u; voffB[i] = (unsigned)(Rb * g.ldb + C) * 2u; }
    const size_t kstep = (size_t)(BK * 2);
    const size_t hstepA = (size_t)HALF * g.lda * 2, hstepB = (size_t)HALF * g.ldb * 2;
    const size_t tstepA = 2 * hstepA, tstepB = 2 * hstepB;
    const unsigned ldsw = (unsigned)wid * 1024u;
    const int aoff = lds_byte(wr * 64 + fr, fq * 8), boff = lds_byte(wc * 32 + fr, fq * 8);
#define PG8_SA(b, h) (((b) * 2 + (h)) * HTB)
#define PG8_SB(b, h) ((4 + (b) * 2 + (h)) * HTB)
#define PG8_STAGE(bufoff, gbase, voff) do { _Pragma("unroll") for (int _i = 0; _i < 2; ++_i) \
        __builtin_amdgcn_global_load_lds((const unsigned*)((const char*)(gbase) + (voff)[_i]), (PG8_LAS unsigned*)(lds + (bufoff) + ldsw + _i * 8192), 16, 0, 0); } while (0)
#define PG8_LDA(dst, b, h) do { _Pragma("unroll") for (int m = 0; m < 4; ++m) _Pragma("unroll") for (int k = 0; k < 2; ++k) dst[m][k] = *(const PG8_LAS bf16x8*)(lds + PG8_SA(b, h) + aoff + m * 2048 + k * 1024); } while (0)
#define PG8_LDB(dst, b, h) do { _Pragma("unroll") for (int n = 0; n < 2; ++n) _Pragma("unroll") for (int k = 0; k < 2; ++k) dst[n][k] = *(const PG8_LAS bf16x8*)(lds + PG8_SB(b, h) + boff + n * 2048 + k * 1024); } while (0)
#define PG8_MMA(ai, bj, At, Bt) do { __builtin_amdgcn_s_setprio(1); _Pragma("unroll") for (int m = 0; m < 4; ++m) _Pragma("unroll") for (int n = 0; n < 2; ++n) _Pragma("unroll") for (int k = 0; k < 2; ++k) \
        acc[ai][bj][m][n] = __builtin_amdgcn_mfma_f32_16x16x32_bf16(Bt[n][k], At[m][k], acc[ai][bj][m][n], 0, 0, 0); __builtin_amdgcn_s_setprio(0); } while (0)
#define PG8_WAIT_V(n) asm volatile("s_waitcnt vmcnt(" #n ")" ::: "memory")
#define PG8_WAIT_L(n) asm volatile("s_waitcnt lgkmcnt(" #n ")" ::: "memory")
#define PG8_BAR __builtin_amdgcn_s_barrier()
#define PG8_SCHED __builtin_amdgcn_sched_barrier(0)
    Unit cur, nxt; int ui = 0;
    if (!S.next(0, cur)) return;
    f32x4 acc[2][2][4][2];
#pragma unroll
    for (int a = 0; a < 2; ++a)
#pragma unroll
        for (int b = 0; b < 2; ++b)
#pragma unroll
            for (int m = 0; m < 4; ++m)
#pragma unroll
                for (int n = 0; n < 2; ++n) acc[a][b][m][n] = (f32x4){0.f, 0.f, 0.f, 0.f};
    bf16x8 At[4][2], B0[2][2], B1[2][2];
    const char* cA = (const char*)g.A + (size_t)cur.pm * tstepA; const char* cB = (const char*)g.Bt + (size_t)cur.pn * tstepB;
    S.a_ready(cur);
    if constexpr (SP2) {
        PG8_STAGE(PG8_SB(0, 0), cB, voffB); PG8_STAGE(PG8_SB(0, 1), cB + hstepB, voffB); PG8_STAGE(PG8_SA(0, 0), cA, voffA); PG8_STAGE(PG8_SA(0, 1), cA + hstepA, voffA);
        if (wr == 1) PG8_BAR;
        PG8_WAIT_V(2); PG8_BAR;
        PG8_STAGE(PG8_SB(1, 0), cB + kstep, voffB); PG8_STAGE(PG8_SA(1, 0), cA + kstep, voffA); PG8_STAGE(PG8_SB(1, 1), cB + hstepB + kstep, voffB);
        PG8_WAIT_V(6); PG8_BAR;
    } else {
        PG8_STAGE(PG8_SB(0, 0), cB, voffB); PG8_STAGE(PG8_SA(0, 0), cA, voffA); PG8_STAGE(PG8_SB(0, 1), cB + hstepB, voffB); PG8_STAGE(PG8_SA(0, 1), cA + hstepA, voffA);
        if (wr == 1) PG8_BAR;
        PG8_WAIT_V(4); PG8_BAR;
        PG8_STAGE(PG8_SB(1, 0), cB + kstep, voffB); PG8_STAGE(PG8_SA(1, 0), cA + kstep, voffA); PG8_STAGE(PG8_SB(1, 1), cB + hstepB + kstep, voffB);
        PG8_WAIT_V(6); PG8_BAR;
    }
    for (;;) {
        const bool has_next = S.next(ui + 1, nxt);
        const char* nA = has_next ? (const char*)g.A + (size_t)nxt.pm * tstepA : cA; const char* nB = has_next ? (const char*)g.Bt + (size_t)nxt.pn * tstepB : cB;
        for (int t = 0; t < nt; t += 2) {
            const bool last = (t == nt - 2);
            const char* a1 = cA + (size_t)(t + 1) * kstep;
            const char* a2 = last ? nA : cA + (size_t)(t + 2) * kstep; const char* b2 = last ? nB : cB + (size_t)(t + 2) * kstep;
            const char* a3 = a2 + kstep; const char* b3 = b2 + kstep;
            if (last && has_next) S.a_ready(nxt);
            if constexpr (SP2) {
            PG8_LDB(B0, 0, 0); PG8_LDB(B1, 0, 1); PG8_SCHED; PG8_LDA(At, 0, 0); PG8_STAGE(PG8_SA(1, 1), a1 + hstepA, voffA);
            PG8_WAIT_V(8); PG8_WAIT_L(0); PG8_BAR; PG8_MMA(0, 0, At, B0); PG8_MMA(0, 1, At, B1); PG8_BAR; PG8_SCHED;
            PG8_LDA(At, 0, 1); PG8_STAGE(PG8_SB(0, 0), b2, voffB); PG8_STAGE(PG8_SB(0, 1), b2 + hstepB, voffB); PG8_STAGE(PG8_SA(0, 0), a2, voffA);
            PG8_WAIT_V(8); PG8_WAIT_L(0); PG8_BAR; PG8_MMA(1, 0, At, B0); PG8_MMA(1, 1, At, B1); PG8_BAR; PG8_SCHED;
            PG8_LDB(B0, 1, 0); PG8_LDB(B1, 1, 1); PG8_SCHED; PG8_LDA(At, 1, 0); PG8_STAGE(PG8_SA(0, 1), a2 + hstepA, voffA);
            PG8_WAIT_V(8); PG8_WAIT_L(0); PG8_BAR; PG8_MMA(0, 0, At, B0); PG8_MMA(0, 1, At, B1); PG8_BAR; PG8_SCHED;
            PG8_LDA(At, 1, 1); PG8_STAGE(PG8_SB(1, 0), b3, voffB); PG8_STAGE(PG8_SB(1, 1), b3 + hstepB, voffB); PG8_STAGE(PG8_SA(1, 0), a3, voffA);
            PG8_WAIT_V(8); PG8_WAIT_L(0); PG8_BAR; PG8_MMA(1, 0, At, B0); PG8_MMA(1, 1, At, B1); PG8_BAR; PG8_SCHED;
            } else {
            PG8_LDB(B0, 0, 0); PG8_SCHED; PG8_LDA(At, 0, 0); PG8_STAGE(PG8_SA(1, 1), a1 + hstepA, voffA);
            PG8_WAIT_L(8); PG8_BAR; PG8_WAIT_L(0); PG8_MMA(0, 0, At, B0); PG8_BAR; PG8_SCHED;
            PG8_LDB(B1, 0, 1); PG8_STAGE(PG8_SB(0, 0), b2, voffB);
            PG8_BAR; PG8_WAIT_L(0); PG8_MMA(0, 1, At, B1); PG8_BAR;
            PG8_LDA(At, 0, 1); PG8_STAGE(PG8_SA(0, 0), a2, voffA);
            PG8_BAR; PG8_WAIT_L(0); PG8_MMA(1, 0, At, B0); PG8_BAR; PG8_SCHED;
            PG8_STAGE(PG8_SB(0, 1), b2 + hstepB, voffB);
            PG8_WAIT_V(6); PG8_BAR; PG8_MMA(1, 1, At, B1); PG8_BAR;
            PG8_LDB(B0, 1, 0); PG8_SCHED; PG8_LDA(At, 1, 0); PG8_STAGE(PG8_SA(0, 1), a2 + hstepA, voffA);
            PG8_WAIT_L(8); PG8_BAR; PG8_WAIT_L(0); PG8_MMA(0, 0, At, B0); PG8_BAR; PG8_SCHED;
            PG8_LDB(B1, 1, 1); PG8_STAGE(PG8_SB(1, 0), b3, voffB);
            PG8_BAR; PG8_WAIT_L(0); PG8_MMA(0, 1, At, B1); PG8_BAR;
            PG8_LDA(At, 1, 1); PG8_STAGE(PG8_SA(1, 0), a3, voffA);
            PG8_BAR; PG8_WAIT_L(0); PG8_MMA(1, 0, At, B0); PG8_BAR; PG8_SCHED;
            PG8_STAGE(PG8_SB(1, 1), b3 + hstepB, voffB);
            PG8_WAIT_V(6); PG8_BAR; PG8_MMA(1, 1, At, B1); PG8_BAR;
            }
        }
        if constexpr (ALIGN_EPI) { if (wr == 0) PG8_BAR; }
        E(acc, cur, wr, wc, fr, fq); S.done(cur);
        if (!has_next) break;
#pragma unroll
        for (int a = 0; a < 2; ++a)
#pragma unroll
            for (int b = 0; b < 2; ++b)
#pragma unroll
                for (int m = 0; m < 4; ++m)
#pragma unroll
                    for (int n = 0; n < 2; ++n) acc[a][b][m][n] = (f32x4){0.f, 0.f, 0.f, 0.f};
        cur = nxt; cA = nA; cB = nB; ++ui;
        if constexpr (ALIGN_EPI) { if (wr == 1) PG8_BAR; }
    }
    PG8_WAIT_V(0);
    if constexpr (!ALIGN_EPI) { if (wr == 0) PG8_BAR; }
    PG8_BAR;
#undef PG8_SA
#undef PG8_SB
#undef PG8_STAGE
#undef PG8_LDA
#undef PG8_LDB
#undef PG8_MMA
#undef PG8_WAIT_V
#undef PG8_WAIT_L
#undef PG8_BAR
#undef PG8_SCHED
}
}

typedef unsigned short bf16;
typedef short bf16x8 __attribute__((ext_vector_type(8)));
typedef short s16x4 __attribute__((ext_vector_type(4)));
typedef float f32x4 __attribute__((ext_vector_type(4)));
typedef float f32x16 __attribute__((ext_vector_type(16)));
typedef unsigned u32x4 __attribute__((ext_vector_type(4)));
typedef unsigned u32x2 __attribute__((ext_vector_type(2)));
#define LAS __attribute__((address_space(3)))

constexpr int M = 16384, DM = 1024, SEQ = 4096, NBATCH = 4;
constexpr int EVEN_IN = 2976, ZLD = 3072;
constexpr int COL_CQ = 2048, COL_CKV = 2304, COL_KR = 2432, COL_BG = 2464;
constexpr float EPS = 1e-6f;
constexpr size_t MiB = 1u << 20;
constexpr size_t WS_MOD = 1 * MiB;
constexpr size_t WS_SSQ_Q = 1 * MiB + 256 * 1024;
constexpr size_t WS_SSQ_KV = 1 * MiB + 512 * 1024;
constexpr size_t WS_COS = 2 * MiB, WS_SIN = 3 * MiB;
constexpr size_t WS_KR = 4 * MiB;
constexpr size_t WS_EWIN = 6 * MiB;
constexpr size_t WS_OWIN = 18 * MiB;
constexpr size_t WS_EWOUT = 30 * MiB;
constexpr size_t WS_OWOUT = 34 * MiB;
constexpr size_t WS_WUQ = 38 * MiB;
constexpr size_t WS_WUKV = 39 * MiB;
constexpr size_t WS_H = 40 * MiB;
constexpr size_t WS_Z = 72 * MiB;
constexpr size_t WS_KV = 168 * MiB;
constexpr size_t WS_CAT = 200 * MiB;
constexpr size_t WS_END = 232 * MiB;
constexpr int LDS_BYTES = 147456;

__device__ __forceinline__ unsigned cvtpk(float lo, float hi) { unsigned r; asm volatile("v_cvt_pk_bf16_f32 %0, %1, %2" : "=v"(r) : "v"(lo), "v"(hi)); return r; }
__device__ __forceinline__ float bflo(unsigned w) { return __uint_as_float(w << 16); }
__device__ __forceinline__ float bfhi(unsigned w) { return __uint_as_float(w & 0xffff0000u); }
__device__ __forceinline__ float sigmoidf_(float x) { return 1.f / (1.f + __expf(-x)); }
__device__ __forceinline__ float siluf_(float x) { return x / (1.f + __expf(-x)); }
__device__ __forceinline__ int opaque_tid(int wave_s) { int l; asm volatile("v_mbcnt_lo_u32_b32 %0, -1, 0\n\tv_mbcnt_hi_u32_b32 %0, -1, %0" : "=v"(l)); asm volatile("" : "+s"(wave_s)); return wave_s * 64 + l; }
__device__ __forceinline__ float wave_sum(float v) {
#pragma unroll
    for (int o = 1; o < 64; o <<= 1) v += __shfl_xor(v, o);
    return v;
}

using pg8::Unit;
struct EpiEvenIn {
    static constexpr bool PERM = true, AFTER_DRAIN = false;
    bf16* Z; float* ssq_q; float* ssq_kv;
    __device__ __forceinline__ void operator()(const f32x4 (&acc)[2][2][4][2], const Unit& u, int wr, int wc, int fr, int fq) const {
        const int row0 = u.pm * 256 + wr * 64 + fr, col0 = u.pn * 256 + wc * 32 + 8 * fq;
#pragma unroll
        for (int ai = 0; ai < 2; ++ai)
#pragma unroll
            for (int m = 0; m < 4; ++m) { bf16* rowp = Z + (size_t)(row0 + ai * 128 + m * 16) * ZLD + col0;
#pragma unroll
                for (int bj = 0; bj < 2; ++bj) { const f32x4 v0 = acc[ai][bj][m][0], v1 = acc[ai][bj][m][1];
                    u32x4 w; w.x = cvtpk(v0[0], v0[1]); w.y = cvtpk(v0[2], v0[3]); w.z = cvtpk(v1[0], v1[1]); w.w = cvtpk(v1[2], v1[3]);
                    *(u32x4*)(rowp + bj * 128) = w; } }
        if (u.pn == 8 || u.pn == 9) {
            float* dst = (u.pn == 8) ? ssq_q : ssq_kv; const int nbj = (u.pn == 8) ? 2 : 1;
#pragma unroll
            for (int ai = 0; ai < 2; ++ai)
#pragma unroll
                for (int m = 0; m < 4; ++m) { float s = 0.f;
#pragma unroll
                    for (int bj = 0; bj < 2; ++bj) if (bj < nbj)
#pragma unroll
                        for (int n = 0; n < 2; ++n) { const f32x4 x = acc[ai][bj][m][n]; s += (x[0] * x[0] + x[1] * x[1]) + (x[2] * x[2] + x[3] * x[3]); }
                    s += __shfl_xor(s, 16); s += __shfl_xor(s, 32);
                    if (fq == 0) dst[(size_t)(row0 + ai * 128 + m * 16) * 4 + wc] = s; }
        }
    }
};
struct EpiQ {
    static constexpr bool PERM = true, AFTER_DRAIN = false;
    bf16* Q; const float* ssq_q;
    __device__ __forceinline__ void operator()(const f32x4 (&acc)[2][2][4][2], const Unit& u, int wr, int wc, int fr, int fq) const {
        const int row0 = u.pm * 256 + wr * 64 + fr, col0 = u.pn * 256 + wc * 32 + 8 * fq;
#pragma unroll
        for (int ai = 0; ai < 2; ++ai)
#pragma unroll
            for (int m = 0; m < 4; ++m) { const int row = row0 + ai * 128 + m * 16;
                const f32x4 pq = *(const f32x4*)(ssq_q + (size_t)row * 4);
                const float rstd = rsqrtf(((pq[0] + pq[1]) + (pq[2] + pq[3])) * (1.f / 256.f) + EPS);
#pragma unroll
                for (int bj = 0; bj < 2; ++bj) {
                    f32x4 v0 = acc[ai][bj][m][0] * rstd, v1 = acc[ai][bj][m][1] * rstd;
                    u32x4 w; w.x = cvtpk(v0[0], v0[1]); w.y = cvtpk(v0[2], v0[3]); w.z = cvtpk(v1[0], v1[1]); w.w = cvtpk(v1[2], v1[3]);
                    *(u32x4*)(Q + (size_t)row * 768 + col0 + bj * 128) = w; } }
    }
};
struct EpiKV {
    static constexpr bool PERM = true, AFTER_DRAIN = false;
    bf16* KV; const float* ssq_kv;
    __device__ __forceinline__ void operator()(const f32x4 (&acc)[2][2][4][2], const Unit& u, int wr, int wc, int fr, int fq) const {
        const int row0 = u.pm * 256 + wr * 64 + fr, col0 = u.pn * 256 + wc * 32 + 8 * fq;
#pragma unroll
        for (int ai = 0; ai < 2; ++ai)
#pragma unroll
            for (int m = 0; m < 4; ++m) { const int row = row0 + ai * 128 + m * 16;
                const f32x4 pq = *(const f32x4*)(ssq_kv + (size_t)row * 4);
                const float rstd = rsqrtf(((pq[0] + pq[1]) + (pq[2] + pq[3])) * (1.f / 128.f) + EPS);
#pragma unroll
                for (int bj = 0; bj < 2; ++bj) { const f32x4 v0 = acc[ai][bj][m][0] * rstd, v1 = acc[ai][bj][m][1] * rstd;
                    u32x4 w; w.x = cvtpk(v0[0], v0[1]); w.y = cvtpk(v0[2], v0[3]); w.z = cvtpk(v1[0], v1[1]); w.w = cvtpk(v1[2], v1[3]);
                    *(u32x4*)(KV + (size_t)row * 1024 + col0 + bj * 128) = w; } }
    }
};
struct EpiPlain {
    static constexpr bool PERM = true, AFTER_DRAIN = false;
    bf16* O; int ldc;
    __device__ __forceinline__ void operator()(const f32x4 (&acc)[2][2][4][2], const Unit& u, int wr, int wc, int fr, int fq) const {
        const int row0 = u.pm * 256 + wr * 64 + fr, col0 = u.pn * 256 + wc * 32 + 8 * fq;
#pragma unroll
        for (int ai = 0; ai < 2; ++ai)
#pragma unroll
            for (int m = 0; m < 4; ++m) { bf16* rowp = O + (size_t)(row0 + ai * 128 + m * 16) * ldc + col0;
#pragma unroll
                for (int bj = 0; bj < 2; ++bj) { const f32x4 v0 = acc[ai][bj][m][0], v1 = acc[ai][bj][m][1];
                    u32x4 w; w.x = cvtpk(v0[0], v0[1]); w.y = cvtpk(v0[2], v0[3]); w.z = cvtpk(v1[0], v1[1]); w.w = cvtpk(v1[2], v1[3]);
                    *(u32x4*)(rowp + bj * 128) = w; } }
    }
};
struct EpiOddIn {
    static constexpr bool PERM = true, AFTER_DRAIN = false;
    bf16* U; bf16* SG;
    __device__ __forceinline__ void operator()(const f32x4 (&acc)[2][2][4][2], const Unit& u, int wr, int wc, int fr, int fq) const {
        const int row0 = u.pm * 256 + wr * 64 + fr;
        if (u.pn < 8) {
            const int col0 = u.pn * 128 + wc * 32 + 8 * fq;
#pragma unroll
            for (int ai = 0; ai < 2; ++ai)
#pragma unroll
                for (int m = 0; m < 4; ++m) { f32x4 v0 = acc[ai][0][m][0], v1 = acc[ai][0][m][1]; const f32x4 g0 = acc[ai][1][m][0], g1 = acc[ai][1][m][1];
#pragma unroll
                    for (int j = 0; j < 4; ++j) { v0[j] *= sigmoidf_(g0[j]); v1[j] *= sigmoidf_(g1[j]); }
                    u32x4 w; w.x = cvtpk(v0[0], v0[1]); w.y = cvtpk(v0[2], v0[3]); w.z = cvtpk(v1[0], v1[1]); w.w = cvtpk(v1[2], v1[3]);
                    *(u32x4*)(U + (size_t)(row0 + ai * 128 + m * 16) * 1024 + col0) = w; }
        } else {
            const int col0 = (u.pn - 8) * 256 + wc * 32 + 8 * fq;
#pragma unroll
            for (int ai = 0; ai < 2; ++ai)
#pragma unroll
                for (int m = 0; m < 4; ++m)
#pragma unroll
                    for (int bj = 0; bj < 2; ++bj) { f32x4 v0 = acc[ai][bj][m][0], v1 = acc[ai][bj][m][1];
#pragma unroll
                        for (int j = 0; j < 4; ++j) { v0[j] = siluf_(v0[j]); v1[j] = siluf_(v1[j]); }
                        u32x4 w; w.x = cvtpk(v0[0], v0[1]); w.y = cvtpk(v0[2], v0[3]); w.z = cvtpk(v1[0], v1[1]); w.w = cvtpk(v1[2], v1[3]);
                        *(u32x4*)(SG + (size_t)(row0 + ai * 128 + m * 16) * 1024 + col0 + bj * 128) = w; }
        }
    }
};

namespace att {
constexpr float SCALE = 0.10206207261596577f;
constexpr float THR = 8.f;
constexpr int SHM_V = 64 * 64 * 2, SHM_K = 64 * 256;
#define KSWZ(row, colB) ((row) * 256 + ((colB) ^ (((row) & 7) << 4)))
#define SBAR() __builtin_amdgcn_sched_barrier(0)
__device__ __forceinline__ int crow(int r, int hi) { return (r & 3) + 8 * (r >> 2) + 4 * hi; }
__device__ __forceinline__ void partialSM(f32x16& p0, f32x16& p1, float& m_reg, float& mn, float& alpha) {
    constexpr float C = SCALE * 1.4426950408889634f;
    float pmax = p0[0];
#pragma unroll
    for (int r = 1; r < 16; ++r) pmax = fmaxf(pmax, p0[r]);
#pragma unroll
    for (int r = 0; r < 16; ++r) pmax = fmaxf(pmax, p1[r]);
    { auto rr = __builtin_amdgcn_permlane32_swap(__float_as_uint(pmax), __float_as_uint(pmax), false, false);
      pmax = fmaxf(__uint_as_float(rr[0]), __uint_as_float(rr[1])); }
    if (__builtin_expect(__all(pmax - m_reg <= THR / SCALE), 1)) { mn = m_reg; alpha = 1.f; }
    else { mn = fmaxf(m_reg, pmax); alpha = __builtin_amdgcn_exp2f((m_reg - mn) * C); m_reg = mn; }
    const float mnC = -mn * C;
#pragma unroll
    for (int r = 0; r < 16; ++r) p0[r] = fmaf(p0[r], C, mnC);
#pragma unroll
    for (int r = 0; r < 16; ++r) p1[r] = fmaf(p1[r], C, mnC);
#pragma unroll
    for (int r = 0; r < 16; ++r) p0[r] = __builtin_amdgcn_exp2f(p0[r]);
}
__device__ __forceinline__ void finishSM(f32x16& p0, f32x16& p1, float alpha, float& l_reg, bf16x8& pa0, bf16x8& pa1, bf16x8& pa2, bf16x8& pa3) {
#pragma unroll
    for (int r = 0; r < 16; ++r) p1[r] = __builtin_amdgcn_exp2f(p1[r]);
    float ps = 0;
#pragma unroll
    for (int r = 0; r < 16; ++r) ps += p0[r];
#pragma unroll
    for (int r = 0; r < 16; ++r) ps += p1[r];
    { auto rr = __builtin_amdgcn_permlane32_swap(__float_as_uint(ps), __float_as_uint(ps), false, false);
      ps = __uint_as_float(rr[0]) + __uint_as_float(rr[1]); }
    l_reg = l_reg * alpha + ps;
#define PK4(P, BASE, OUT) do { unsigned a0 = cvtpk(P[BASE + 0], P[BASE + 1]), a1 = cvtpk(P[BASE + 2], P[BASE + 3]);   \
    unsigned b0 = cvtpk(P[BASE + 4], P[BASE + 5]), b1 = cvtpk(P[BASE + 6], P[BASE + 7]);                              \
    auto r0 = __builtin_amdgcn_permlane32_swap(a0, b0, false, false); auto r1 = __builtin_amdgcn_permlane32_swap(a1, b1, false, false); \
    u32x4 w = {r0[0], r1[0], r0[1], r1[1]}; OUT = *reinterpret_cast<bf16x8*>(&w); } while (0)
    PK4(p0, 0, pa0); PK4(p0, 8, pa1); PK4(p1, 0, pa2); PK4(p1, 8, pa3);
#undef PK4
}
__device__ __forceinline__ void qkt(f32x16& p0, f32x16& p1, const char* Ks, const bf16x8* qr, int r32, int hi, bool active) {
    if (active) {
        p0 = f32x16{}; p1 = f32x16{};
#pragma unroll
        for (int d0 = 0; d0 < 6; ++d0) { const int cb = (d0 * 16 + hi * 8) * 2;
            const bf16x8 b0 = *reinterpret_cast<const bf16x8*>(Ks + KSWZ(r32, cb));
            const bf16x8 b1 = *reinterpret_cast<const bf16x8*>(Ks + KSWZ(32 + r32, cb));
            p0 = __builtin_amdgcn_mfma_f32_32x32x16_bf16(b0, qr[d0], p0, 0, 0, 0);
            p1 = __builtin_amdgcn_mfma_f32_32x32x16_bf16(b1, qr[d0], p1, 0, 0, 0); }
    } else {
#pragma unroll
        for (int r = 0; r < 16; ++r) { p0[r] = -1e30f; p1[r] = -1e30f; }
    }
}
__device__ __forceinline__ int v_st(int k, int c) { const int kk = (k & ~0xC) | ((k & 4) << 1) | ((k & 8) >> 1); return ((kk >> 3) * 2 + (c >> 5)) * 512 + ((kk & 7) * 32 + (c & 31)) * 2; }
__device__ __forceinline__ int v_rd_base(int lane) { return ((lane & 3) << 3) | (((lane >> 2) & 3) << 6) | (((lane >> 4) & 1) << 5) | (((lane >> 5) & 1) << 8); }
constexpr int v_rd_off(int d0, int ks, int half) { return d0 * 512 + ks * 2048 + half * 1024; }
template <int OFF> __device__ __forceinline__ s16x4 tr_read(int vb) {
    s16x4 r; asm volatile("ds_read_b64_tr_b16 %0, %1 offset:%2" : "=&v"(r) : "v"(vb), "i"(OFF) : "memory"); return r;
}
template <int D0> __device__ __forceinline__ void pv_one(f32x16& od, int vb, bf16x8 pa0, bf16x8 pa1, bf16x8 pa2, bf16x8 pa3) {
    const s16x4 l0 = tr_read<v_rd_off(D0, 0, 0)>(vb), h0 = tr_read<v_rd_off(D0, 0, 1)>(vb), l1 = tr_read<v_rd_off(D0, 1, 0)>(vb), h1 = tr_read<v_rd_off(D0, 1, 1)>(vb);
    const s16x4 l2 = tr_read<v_rd_off(D0, 2, 0)>(vb), h2 = tr_read<v_rd_off(D0, 2, 1)>(vb), l3 = tr_read<v_rd_off(D0, 3, 0)>(vb), h3 = tr_read<v_rd_off(D0, 3, 1)>(vb);
    asm volatile("s_waitcnt lgkmcnt(0)" ::: "memory"); SBAR();
#define PK(L, H) (bf16x8){L[0], L[1], L[2], L[3], H[0], H[1], H[2], H[3]}
    od = __builtin_amdgcn_mfma_f32_32x32x16_bf16(pa0, PK(l0, h0), od, 0, 0, 0);
    od = __builtin_amdgcn_mfma_f32_32x32x16_bf16(pa1, PK(l1, h1), od, 0, 0, 0);
    od = __builtin_amdgcn_mfma_f32_32x32x16_bf16(pa2, PK(l2, h2), od, 0, 0, 0);
    od = __builtin_amdgcn_mfma_f32_32x32x16_bf16(pa3, PK(l3, h3), od, 0, 0, 0);
#undef PK
}
__device__ __forceinline__ void pv_d0(f32x16* o, int vb, bf16x8 pa0, bf16x8 pa1, bf16x8 pa2, bf16x8 pa3) {
    pv_one<0>(o[0], vb, pa0, pa1, pa2, pa3); pv_one<1>(o[1], vb, pa0, pa1, pa2, pa3);
}

__device__ __forceinline__ void attn_unit(int b, int h, int qb, const bf16* __restrict__ Q, const bf16* __restrict__ KV, const bf16* __restrict__ KR,
                                          const bf16* __restrict__ Z, bf16* __restrict__ CAT, const float* __restrict__ cosT, const float* __restrict__ sinT, char* lds, int wave_s) {
    const int tid = opaque_tid(wave_s), wid = tid >> 6, lane = tid & 63, r32 = lane & 31, hi = lane >> 5;
    char* V_lds = lds; char* K_lds = lds + 2 * SHM_V;
    float* ws = (float*)(lds + 2 * SHM_V + 2 * SHM_K) + wid * 64; float* li_l = ws; float* al_l = ws + 32;
    float m_reg = -1e30f, l_reg = 0; f32x16 o[2] = {}; bf16x8 qr[6];
    const long rowbase = (long)b * SEQ; const int q0 = qb * 256;
    const bf16* Qw = Q + (rowbase + q0 + wid * 32 + r32) * 768 + h * 96 + hi * 8;
#pragma unroll
    for (int d0 = 0; d0 < 6; ++d0) qr[d0] = *reinterpret_cast<const bf16x8*>(Qw + d0 * 16);
    {
        const size_t qrow = (size_t)(rowbase + q0 + wid * 32 + r32);
        const f32x4 c0 = *(const f32x4*)(cosT + qrow * 16 + 8 * hi), c1 = *(const f32x4*)(cosT + qrow * 16 + 8 * hi + 4);
        const f32x4 s0 = *(const f32x4*)(sinT + qrow * 16 + 8 * hi), s1 = *(const f32x4*)(sinT + qrow * 16 + 8 * hi + 4);
        const u32x4 t1w = __builtin_bit_cast(u32x4, qr[4]), t2w = __builtin_bit_cast(u32x4, qr[5]); u32x4 o1, o2;
#pragma unroll
        for (int q = 0; q < 4; ++q) { const float cl = q < 2 ? c0[2 * q] : c1[2 * q - 4], ch = q < 2 ? c0[2 * q + 1] : c1[2 * q - 3];
            const float sl = q < 2 ? s0[2 * q] : s1[2 * q - 4], sh = q < 2 ? s0[2 * q + 1] : s1[2 * q - 3];
            const float a_lo = bflo(t1w[q]), a_hi = bfhi(t1w[q]), b_lo = bflo(t2w[q]), b_hi = bfhi(t2w[q]);
            o1[q] = cvtpk(a_lo * cl - b_lo * sl, a_hi * ch - b_hi * sh); o2[q] = cvtpk(b_lo * cl + a_lo * sl, b_hi * ch + a_hi * sh); }
        qr[4] = __builtin_bit_cast(bf16x8, o1); qr[5] = __builtin_bit_cast(bf16x8, o2);
    }
    const int sr = tid >> 3, sc = (tid & 7) * 8, sr2 = (tid & 255) >> 2, sc2 = (tid & 3) * 8;
    const int vst = v_st(sr, sc), kst = KSWZ(sr, sc * 2), kst2 = KSWZ(sr2, (64 + sc2) * 2);
    const bf16* kvsrc = KV + (rowbase + sr) * 1024 + h * 128 + sc;
    const bf16* krsrc = KR + (rowbase + sr2) * 32 + sc2;
    const int vb0 = (int)(uintptr_t)V_lds + v_rd_base(lane);
    struct { bf16x8 kn, vv, kr; } sr_[2];
#define SLOAD(i, k0) do { sr_[i].kn = *reinterpret_cast<const bf16x8*>(kvsrc + (long)(k0) * 1024); sr_[i].vv = *reinterpret_cast<const bf16x8*>(kvsrc + (long)(k0) * 1024 + 64); \
    sr_[i].kr = *reinterpret_cast<const bf16x8*>(krsrc + (long)(k0) * 32); } while (0)
#define SWRITE(bb, i) do { *(bf16x8*)(V_lds + (bb) * SHM_V + vst) = sr_[i].vv; *(bf16x8*)(K_lds + (bb) * SHM_K + kst) = sr_[i].kn; *(bf16x8*)(K_lds + (bb) * SHM_K + kst2) = sr_[i].kr; } while (0)
#define SWAIT() asm volatile("s_waitcnt vmcnt(3)" ::: "memory")
#define RESC(a) do { if (__any((a) < 1.f)) { if (hi == 0) al_l[r32] = (a); asm volatile("s_waitcnt lgkmcnt(0)" ::: "memory"); \
    _Pragma("unroll") for (int d = 0; d < 2; ++d) _Pragma("unroll") for (int r = 0; r < 16; ++r) o[d][r] *= al_l[crow(r, hi)]; } } while (0)
    f32x16 pA0, pA1, pB0, pB1; float mnA, mnB, alA, alB; bf16x8 pa0, pa1, pa2, pa3;
    const int NT = q0 / 64 + 4, jmax = q0 / 64 + (wid >> 1);
    SLOAD(0, 0); asm volatile("s_waitcnt vmcnt(0)" ::: "memory"); SWRITE(0, 0); __syncthreads();
    qkt(pA0, pA1, K_lds, qr, r32, hi, true); partialSM(pA0, pA1, m_reg, mnA, alA);
    SLOAD(1, 64); if (2 < NT) SLOAD(0, 128);
    SWAIT(); SWRITE(1, 1); __syncthreads();
    for (int j = 1; j + 1 < NT; j += 2) {
        SBAR(); qkt(pB0, pB1, K_lds + SHM_K, qr, r32, hi, j <= jmax);
        finishSM(pA0, pA1, alA, l_reg, pa0, pa1, pa2, pa3); SBAR();
        SLOAD(1, (j + 2) * 64); SBAR();
        pv_d0(o, vb0, pa0, pa1, pa2, pa3); partialSM(pB0, pB1, m_reg, mnB, alB);
        __syncthreads(); SWAIT(); SWRITE(0, 0);
        RESC(alB); __syncthreads();
        SBAR(); qkt(pA0, pA1, K_lds, qr, r32, hi, j + 1 <= jmax);
        finishSM(pB0, pB1, alB, l_reg, pa0, pa1, pa2, pa3); SBAR();
        if (j + 3 < NT) SLOAD(0, (j + 3) * 64); SBAR();
        pv_d0(o, vb0 + SHM_V, pa0, pa1, pa2, pa3); partialSM(pA0, pA1, m_reg, mnA, alA);
        __syncthreads(); SWAIT(); SWRITE(1, 1);
        RESC(alA); __syncthreads();
    }
    SBAR(); qkt(pB0, pB1, K_lds + SHM_K, qr, r32, hi, NT - 1 <= jmax);
    finishSM(pA0, pA1, alA, l_reg, pa0, pa1, pa2, pa3); SBAR();
    pv_d0(o, vb0, pa0, pa1, pa2, pa3); partialSM(pB0, pB1, m_reg, mnB, alB);
    __syncthreads(); RESC(alB);
    finishSM(pB0, pB1, alB, l_reg, pa0, pa1, pa2, pa3); SBAR();
    pv_d0(o, vb0 + SHM_V, pa0, pa1, pa2, pa3);
    if (hi == 0) li_l[r32] = l_reg; asm volatile("s_waitcnt lgkmcnt(0)" ::: "memory");
    float rli[16];
#pragma unroll
    for (int r = 0; r < 16; ++r) rli[r] = __builtin_amdgcn_rcpf(li_l[crow(r, hi)]);
    const long orow0 = rowbase + q0 + wid * 32;
#pragma unroll
    for (int r = 0; r < 16; ++r) { const long row = orow0 + crow(r, hi);
#pragma unroll
        for (int d0 = 0; d0 < 2; ++d0) { const float gz = bflo((unsigned)Z[row * ZLD + COL_BG + h * 64 + d0 * 32 + r32]);
            const float v = o[d0][r] * rli[r] * siluf_(gz);
            CAT[row * 1024 + 512 + h * 64 + d0 * 32 + r32] = (bf16)(cvtpk(v, v) & 0xffffu); } }
    __syncthreads();
#undef SLOAD
#undef SWRITE
#undef SWAIT
#undef RESC
}
#undef SBAR
}

struct Args {
    const float* x; const float* c; const int* pos; const float* ada_w; const float* ada_b; const float* pre_g; const float* post_g;
    const float* e_win; const float* e_scw; const float* e_scb; const float* e_qg; const float* e_kvg; const float* e_wuq; const float* e_wukv; const float* e_wout;
    const float* o_win; const float* o_cw; const float* o_cb; const float* o_lng; const float* o_lnb; const float* o_wout;
    float* out; unsigned char* ws; int ph_lo, ph_hi;
};

__device__ __forceinline__ void tr_item(const float* __restrict__ W, int N, const float* __restrict__ gk, bf16* __restrict__ WT, int ldt, int dst_row0, float* scr, int k0, int n0, int lane) {
#pragma unroll 8
    for (int i = 0; i < 32; ++i) { const int kk = 2 * i + (lane >> 5); float v = W[(size_t)(k0 + kk) * N + n0 + (lane & 31)]; if (gk) v *= gk[k0 + kk]; scr[kk * 33 + (lane & 31)] = v; }
    asm volatile("s_waitcnt lgkmcnt(0)" ::: "memory");
    const int c = lane & 7;
#pragma unroll
    for (int j = 0; j < 4; ++j) { const int n = (lane >> 3) + 8 * j; const float* s = scr + (8 * c) * 33 + n;
        u32x4 o; o.x = cvtpk(s[0 * 33], s[1 * 33]); o.y = cvtpk(s[2 * 33], s[3 * 33]); o.z = cvtpk(s[4 * 33], s[5 * 33]); o.w = cvtpk(s[6 * 33], s[7 * 33]);
        *(u32x4*)(WT + (size_t)(dst_row0 + n) * ldt + k0 + 8 * c) = o; }
    asm volatile("s_waitcnt lgkmcnt(0)" ::: "memory");
}

__device__ __forceinline__ void p0_phase(const Args& a, char* lds, int G, int wave_s) {
    const int tid = opaque_tid(wave_s), lane = tid & 63, wave = wave_s;
    unsigned char* ws = a.ws;
    {
        float* cact = (float*)lds; float* part = (float*)(lds + 16384); float* mod = (float*)(ws + WS_MOD);
        for (int task = blockIdx.x; task < 192; task += G) {
            const int l = task / 48, n0 = (task % 48) * 64;
            for (int i = tid; i < 4096; i += 512) { const float v = a.c[i]; cact[i] = siluf_(v); }
            __syncthreads();
            const float* W = a.ada_w + (size_t)l * 1024 * 3072 + n0 + lane; const int k0 = wave * 128;
            float a0 = 0.f, a1 = 0.f, a2 = 0.f, a3 = 0.f;
#pragma unroll 8
            for (int k = 0; k < 128; ++k) { const float w = W[(size_t)(k0 + k) * 3072]; a0 += cact[k0 + k] * w; a1 += cact[1024 + k0 + k] * w; a2 += cact[2048 + k0 + k] * w; a3 += cact[3072 + k0 + k] * w; }
            part[(wave * 4 + 0) * 64 + lane] = a0; part[(wave * 4 + 1) * 64 + lane] = a1; part[(wave * 4 + 2) * 64 + lane] = a2; part[(wave * 4 + 3) * 64 + lane] = a3;
            __syncthreads();
            if (tid < 256) { const int b = tid >> 6, j = tid & 63; float s = 0.f;
#pragma unroll
                for (int w = 0; w < 8; ++w) s += part[(w * 4 + b) * 64 + j];
                mod[(size_t)(l * 4 + b) * 3072 + n0 + j] = s + a.ada_b[l * 3072 + n0 + j]; }
            __syncthreads();
        }
    }
    {
        float* scr = (float*)(lds + wave * 16384);
        const int gw = blockIdx.x * 8 + wave, NGW = G * 8;
        constexpr int I_EW = 16 * 93, I_UQ = 4 * 24, I_UKV = 2 * 32, I_WO = 16 * 32, I_OW = 16 * 96;
        constexpr int NITEMS = 2 * (I_EW + I_UQ + I_UKV + I_WO + I_OW + I_WO);
        for (int it = gw; it < NITEMS; it += NGW) {
            int r = it;
            if (r < 2 * I_EW) { const int li = r / I_EW, rr = r % I_EW, kb = rr / 93, nb = rr % 93;
                tr_item(a.e_win + (size_t)li * 1024 * EVEN_IN, EVEN_IN, nullptr, (bf16*)(ws + WS_EWIN) + (size_t)li * 3072 * 1024, 1024, 32 * nb, scr, 64 * kb, 32 * nb, lane); continue; } r -= 2 * I_EW;
            if (r < 2 * I_OW) { const int li = r / I_OW, rr = r % I_OW, kb = rr / 96, nb = rr % 96; const int n0 = 32 * nb;
                int drow; if (n0 < 2048) { const int part = n0 >> 10, ch = n0 & 1023; drow = 256 * (ch >> 7) + 128 * part + (ch & 127); } else drow = n0;
                tr_item(a.o_win + (size_t)li * 1024 * 3072, 3072, nullptr, (bf16*)(ws + WS_OWIN) + (size_t)li * 3072 * 1024, 1024, drow, scr, 64 * kb, n0, lane); continue; } r -= 2 * I_OW;
            if (r < 2 * I_WO) { const int li = r / I_WO, rr = r % I_WO, kb = rr / 32, nb = rr % 32;
                tr_item(a.e_wout + (size_t)li * 1024 * 1024, 1024, nullptr, (bf16*)(ws + WS_EWOUT) + (size_t)li * 1024 * 1024, 1024, 32 * nb, scr, 64 * kb, 32 * nb, lane); continue; } r -= 2 * I_WO;
            if (r < 2 * I_WO) { const int li = r / I_WO, rr = r % I_WO, kb = rr / 32, nb = rr % 32;
                tr_item(a.o_wout + (size_t)li * 1024 * 1024, 1024, nullptr, (bf16*)(ws + WS_OWOUT) + (size_t)li * 1024 * 1024, 1024, 32 * nb, scr, 64 * kb, 32 * nb, lane); continue; } r -= 2 * I_WO;
            if (r < 2 * I_UQ) { const int li = r / I_UQ, rr = r % I_UQ, kb = rr / 24, nb = rr % 24;
                tr_item(a.e_wuq + (size_t)li * 256 * 768, 768, a.e_qg + li * 256, (bf16*)(ws + WS_WUQ) + (size_t)li * 768 * 256, 256, 32 * nb, scr, 64 * kb, 32 * nb, lane); continue; } r -= 2 * I_UQ;
            { const int li = r / I_UKV, rr = r % I_UKV, kb = rr / 32, nb = rr % 32;
                tr_item(a.e_wukv + (size_t)li * 128 * 1024, 1024, a.e_kvg + li * 128, (bf16*)(ws + WS_WUKV) + (size_t)li * 1024 * 128, 128, 32 * nb, scr, 64 * kb, 32 * nb, lane); }
        }
    }
    {
        const int gt = blockIdx.x * 512 + tid, NGT = G * 512;
        for (int e = gt; e < 2 * 96 * 128; e += NGT) { const int li = e / (96 * 128), rr = e % (96 * 128);
            *(u32x4*)((bf16*)(ws + WS_EWIN) + (size_t)li * 3072 * 1024 + (size_t)EVEN_IN * 1024 + (size_t)rr * 8) = (u32x4){0u, 0u, 0u, 0u}; }
        float* cosT = (float*)(ws + WS_COS); float* sinT = (float*)(ws + WS_SIN);
        for (int e = gt; e < M * 16; e += NGT) { const int m = e >> 4, i = e & 15;
            const float inv_freq = 1.0f / powf(10000.0f, (float)(2 * i) * (1.0f / 32.0f));
            const float x = (float)a.pos[m] * inv_freq;
            const float n = rintf(x * 0.15915494309189535f);
            float r = fmaf(-n, 6.28125f, x); r = fmaf(-n, 1.9353071795864769e-3f, r);
            cosT[e] = cosf(r); sinT[e] = sinf(r); }
    }
}

template <bool HAS_POST, bool HAS_PRE>
__device__ __forceinline__ void norm_phase(const float* __restrict__ xin, float* __restrict__ xout, bf16* Hb, const float* mod_prev, const float* postg, const float* mod_next, const float* preg,
                                           int G, int wave_s) {
    const int tid = opaque_tid(wave_s), lane = tid & 63, wave = wave_s;
    const int gw = blockIdx.x * 8 + wave, NGW = G * 8;
    for (int ch = gw; ch < M / 8; ch += NGW) {
        const int row0 = ch * 8, b = row0 / SEQ;
        f32x4 GA[4], PB[4], SH[4];
#pragma unroll
        for (int j = 0; j < 4; ++j) { const int c = 4 * lane + 256 * j;
            if (HAS_POST) { GA[j] = *(const f32x4*)(mod_prev + (size_t)b * 3072 + 2048 + c) * *(const f32x4*)(postg + c); }
            if (HAS_PRE) { PB[j] = *(const f32x4*)(preg + c) * (*(const f32x4*)(mod_next + (size_t)b * 3072 + 1024 + c) + 1.0f); SH[j] = *(const f32x4*)(mod_next + (size_t)b * 3072 + c); } }
#pragma unroll 2
        for (int rr = 0; rr < 8; ++rr) { const size_t row = row0 + rr;
            f32x4 xv[4];
#pragma unroll
            for (int j = 0; j < 4; ++j) xv[j] = *(const f32x4*)(xin + row * DM + 4 * lane + 256 * j);
            if (HAS_POST) {
                f32x4 yv[4]; float s = 0.f;
#pragma unroll
                for (int j = 0; j < 4; ++j) { const u32x2 w = *(const u32x2*)(Hb + row * DM + 4 * lane + 256 * j); yv[j] = (f32x4){bflo(w.x), bfhi(w.x), bflo(w.y), bfhi(w.y)};
                    s += (yv[j][0] * yv[j][0] + yv[j][1] * yv[j][1]) + (yv[j][2] * yv[j][2] + yv[j][3] * yv[j][3]); }
                const float rstd = rsqrtf(wave_sum(s) * (1.f / DM) + EPS);
#pragma unroll
                for (int j = 0; j < 4; ++j) { xv[j] = xv[j] + GA[j] * (yv[j] * rstd); *(f32x4*)(xout + row * DM + 4 * lane + 256 * j) = xv[j]; }
            }
            if (HAS_PRE) {
                float s = 0.f;
#pragma unroll
                for (int j = 0; j < 4; ++j) s += (xv[j][0] * xv[j][0] + xv[j][1] * xv[j][1]) + (xv[j][2] * xv[j][2] + xv[j][3] * xv[j][3]);
                const float rstd = rsqrtf(wave_sum(s) * (1.f / DM) + EPS);
#pragma unroll
                for (int j = 0; j < 4; ++j) { const f32x4 hv = (xv[j] * rstd) * PB[j] + SH[j]; u32x2 w; w.x = cvtpk(hv[0], hv[1]); w.y = cvtpk(hv[2], hv[3]);
                    *(u32x2*)(Hb + row * DM + 4 * lane + 256 * j) = w; }
            }
        }
    }
}

__device__ __forceinline__ void ew_even_phase(const bf16* __restrict__ Z, bf16* __restrict__ CAT, bf16* __restrict__ KR, const float* __restrict__ scw, const float* __restrict__ scb,
                                              const float* __restrict__ cosT, const float* __restrict__ sinT, int G, int wave_s) {
    const int tid = opaque_tid(wave_s), lane = tid & 63, wave = wave_s;
    const int gw = blockIdx.x * 8 + wave, NGW = G * 8;
    const int c0 = 8 * lane;
    float w0[8], w1[8], w2[8], bb[8];
#pragma unroll
    for (int j = 0; j < 8; ++j) { w0[j] = scw[c0 + j]; w1[j] = scw[512 + c0 + j]; w2[j] = scw[1024 + c0 + j]; bb[j] = scb[c0 + j]; }
    for (int ch = gw; ch < M / 8; ch += NGW) {
        const int row0 = ch * 8, s0 = row0 % SEQ;
        float pm2[8], pm1[8];
        if (s0 == 0) {
#pragma unroll
            for (int j = 0; j < 8; ++j) { pm2[j] = 0.f; pm1[j] = 0.f; }
        } else {
            const u32x4 c2 = *(const u32x4*)(Z + (size_t)(row0 - 2) * ZLD + 512 + c0), x2 = *(const u32x4*)(Z + (size_t)(row0 - 2) * ZLD + 1024 + c0);
            const u32x4 c1 = *(const u32x4*)(Z + (size_t)(row0 - 1) * ZLD + 512 + c0), x1 = *(const u32x4*)(Z + (size_t)(row0 - 1) * ZLD + 1024 + c0);
#pragma unroll
            for (int q = 0; q < 4; ++q) { pm2[2 * q] = bflo(c2[q]) * bflo(x2[q]); pm2[2 * q + 1] = bfhi(c2[q]) * bfhi(x2[q]); pm1[2 * q] = bflo(c1[q]) * bflo(x1[q]); pm1[2 * q + 1] = bfhi(c1[q]) * bfhi(x1[q]); }
        }
#pragma unroll 2
        for (int rr = 0; rr < 8; ++rr) { const size_t row = row0 + rr; const bf16* zr = Z + row * ZLD;
            const u32x4 vb = *(const u32x4*)(zr + c0), vc = *(const u32x4*)(zr + 512 + c0), vx = *(const u32x4*)(zr + 1024 + c0), vg = *(const u32x4*)(zr + 1536 + c0);
            float p[8], ab[8], ag[8];
#pragma unroll
            for (int q = 0; q < 4; ++q) { p[2 * q] = bflo(vc[q]) * bflo(vx[q]); p[2 * q + 1] = bfhi(vc[q]) * bfhi(vx[q]); ab[2 * q] = bflo(vb[q]); ab[2 * q + 1] = bfhi(vb[q]); ag[2 * q] = bflo(vg[q]); ag[2 * q + 1] = bfhi(vg[q]); }
            float o[8];
#pragma unroll
            for (int j = 0; j < 8; ++j) { const float cv = w0[j] * pm2[j] + w1[j] * pm1[j] + w2[j] * p[j] + bb[j]; o[j] = ab[j] * cv * siluf_(ag[j]); pm2[j] = pm1[j]; pm1[j] = p[j]; }
            u32x4 w; w.x = cvtpk(o[0], o[1]); w.y = cvtpk(o[2], o[3]); w.z = cvtpk(o[4], o[5]); w.w = cvtpk(o[6], o[7]);
            *(u32x4*)(CAT + row * 1024 + c0) = w;
            if (lane < 16) { const float t1 = bflo((unsigned)zr[COL_KR + lane]), t2 = bflo((unsigned)zr[COL_KR + 16 + lane]); const float cs = cosT[row * 16 + lane], sn = sinT[row * 16 + lane];
                const float o1 = t1 * cs - t2 * sn, o2 = t2 * cs + t1 * sn;
                KR[row * 32 + lane] = (bf16)(cvtpk(o1, o1) & 0xffffu); KR[row * 32 + 16 + lane] = (bf16)(cvtpk(o2, o2) & 0xffffu); }
        }
    }
}

__device__ __forceinline__ void conv_odd_phase(const bf16* __restrict__ U, const bf16* __restrict__ SG, bf16* __restrict__ A2, const float* __restrict__ cw, const float* __restrict__ cb,
                                               const float* __restrict__ lng, const float* __restrict__ lnb, char* lds, int G, int wave_s) {
    const int tid = opaque_tid(wave_s), lane = tid & 63, wave = wave_s;
    typedef float f32x2 __attribute__((ext_vector_type(2)));
    float* cbuf = (float*)lds;
    f32x2 w[31];
#pragma unroll
    for (int k = 0; k < 31; ++k) w[k] = *(const f32x2*)(cw + k * 1024 + 2 * tid);
    const f32x2 bias = *(const f32x2*)(cb + 2 * tid);
    f32x4 lg[4], lb[4];
#pragma unroll
    for (int j = 0; j < 4; ++j) { lg[j] = *(const f32x4*)(lng + 4 * lane + 256 * j); lb[j] = *(const f32x4*)(lnb + 4 * lane + 256 * j); }
    for (int tile = blockIdx.x; tile < M / 16; tile += G) {
        const int t0 = tile * 16, s0 = t0 % SEQ;
        f32x2 acc[16];
#pragma unroll
        for (int j = 0; j < 16; ++j) acc[j] = bias;
#pragma unroll
        for (int i = 0; i < 46; ++i) {
            f32x2 v = (f32x2){0.f, 0.f};
            if (s0 - 30 + i >= 0) { const unsigned uw = *(const unsigned*)(U + (size_t)(t0 - 30 + i) * 1024 + 2 * tid); v = (f32x2){bflo(uw), bfhi(uw)}; }
#pragma unroll
            for (int j = 0; j < 16; ++j) { const int k = i - j; if (k >= 0 && k <= 30) acc[j] += w[k] * v; }
        }
#pragma unroll
        for (int j = 0; j < 16; ++j) *(f32x2*)(cbuf + j * 1024 + 2 * tid) = acc[j];
        __syncthreads();
#pragma unroll
        for (int jj = 0; jj < 2; ++jj) { const int j = 2 * wave + jj; const size_t row = t0 + j;
            f32x4 v[4]; float s = 0.f;
#pragma unroll
            for (int q = 0; q < 4; ++q) { v[q] = *(const f32x4*)(cbuf + j * 1024 + 4 * lane + 256 * q); s += (v[q][0] + v[q][1]) + (v[q][2] + v[q][3]); }
            const float mean = wave_sum(s) * (1.f / 1024.f); float s2 = 0.f;
#pragma unroll
            for (int q = 0; q < 4; ++q) { v[q] = v[q] - mean; s2 += (v[q][0] * v[q][0] + v[q][1] * v[q][1]) + (v[q][2] * v[q][2] + v[q][3] * v[q][3]); }
            const float rstd = rsqrtf(wave_sum(s2) * (1.f / 1024.f) + EPS);
#pragma unroll
            for (int q = 0; q < 4; ++q) { const u32x2 gw_ = *(const u32x2*)(SG + row * 1024 + 4 * lane + 256 * q);
                f32x4 y = (v[q] * rstd) * lg[q] + lb[q];
                const f32x4 sg = (f32x4){bflo(gw_.x), bfhi(gw_.x), bflo(gw_.y), bfhi(gw_.y)};
#pragma unroll
                for (int e = 0; e < 4; ++e) y[e] = siluf_(y[e]) * sg[e];
                u32x2 ow; ow.x = cvtpk(y[0], y[1]); ow.y = cvtpk(y[2], y[3]);
                *(u32x2*)(A2 + row * 1024 + 4 * lane + 256 * q) = ow; }
        }
        __syncthreads();
    }
}

__global__ void __launch_bounds__(512, 2) mk_fwd(Args a) {
    extern __shared__ __attribute__((aligned(16))) unsigned char lds[];
    cg::grid_group grid = cg::this_grid();
    const int G = gridDim.x;
    const int wave_s = __builtin_amdgcn_readfirstlane((int)threadIdx.x >> 6);
    const int vcu = (G % 8 == 0) ? ((int)blockIdx.x % 8) * (G / 8) + (int)blockIdx.x / 8 : (int)blockIdx.x;
    unsigned char* ws = a.ws;
    float* mod = (float*)(ws + WS_MOD); float* ssq_q = (float*)(ws + WS_SSQ_Q); float* ssq_kv = (float*)(ws + WS_SSQ_KV);
    float* cosT = (float*)(ws + WS_COS); float* sinT = (float*)(ws + WS_SIN);
    bf16* KR = (bf16*)(ws + WS_KR); bf16* Hb = (bf16*)(ws + WS_H); bf16* Zb = (bf16*)(ws + WS_Z); bf16* KVb = (bf16*)(ws + WS_KV); bf16* CAT = (bf16*)(ws + WS_CAT);
    PG8_LAS unsigned char* ldsL = (PG8_LAS unsigned char*)lds;
    int ph = 0; const int lo = a.ph_lo, hi = a.ph_hi;
#define PH_BEGIN if (ph >= lo && ph < hi) {
#define PH_END } ++ph; if (ph > lo && ph < hi) grid.sync();

    PH_BEGIN p0_phase(a, (char*)lds, G, wave_s); PH_END
    PH_BEGIN norm_phase<false, true>(a.x, nullptr, Hb, nullptr, nullptr, mod, a.pre_g, G, wave_s); PH_END

#define LAYER_BODY(layer) do { \
        const int li = layer >> 1; \
        if ((layer & 1) == 0) { \
            PH_BEGIN \
                pg8::Gemm g{Hb, 1024, (const bf16*)(ws + WS_EWIN) + (size_t)li * 3072 * 1024, 1024, M, 3072, 1024, wave_s}; pg8::StaticOrder S; S.init(M, 3072, G, (int)blockIdx.x); \
                EpiEvenIn E{Zb, ssq_q, ssq_kv}; \
                pg8::gemm_phase<EpiEvenIn, pg8::StaticOrder, true, true>(ldsL, g, S, E); \
            PH_END \
            PH_BEGIN \
                { pg8::Gemm g{Zb + COL_CQ, ZLD, (const bf16*)(ws + WS_WUQ) + (size_t)li * 768 * 256, 256, M, 768, 256, wave_s}; pg8::StaticOrder S; S.init(M, 768, G, (int)blockIdx.x); \
                  EpiQ E{Hb, ssq_q}; \
                  pg8::gemm_phase<EpiQ, pg8::StaticOrder, true, true>(ldsL, g, S, E); } \
                { pg8::Gemm g{Zb + COL_CKV, ZLD, (const bf16*)(ws + WS_WUKV) + (size_t)li * 1024 * 128, 128, M, 1024, 128, wave_s}; pg8::StaticOrder S; S.init(M, 1024, G, (int)blockIdx.x); \
                  EpiKV E{KVb, ssq_kv}; \
                  pg8::gemm_phase<EpiKV, pg8::StaticOrder, true, true>(ldsL, g, S, E); } \
                ew_even_phase(Zb, CAT, KR, a.e_scw + li * 3 * 512, a.e_scb + li * 512, cosT, sinT, G, wave_s); \
            PH_END \
            PH_BEGIN \
                for (int pi = vcu; pi < 256; pi += G) { const int bh = pi >> 3, s = pi & 7; \
                    att::attn_unit(bh >> 3, bh & 7, 15 - s, Hb, KVb, KR, Zb, CAT, cosT, sinT, (char*)lds, wave_s); \
                    att::attn_unit(bh >> 3, bh & 7, s, Hb, KVb, KR, Zb, CAT, cosT, sinT, (char*)lds, wave_s); } \
            PH_END \
            PH_BEGIN \
                pg8::Gemm g{CAT, 1024, (const bf16*)(ws + WS_EWOUT) + (size_t)li * 1024 * 1024, 1024, M, 1024, 1024, wave_s}; pg8::StaticOrder S; S.init(M, 1024, G, (int)blockIdx.x); \
                EpiPlain E{Hb, 1024}; \
                pg8::gemm_phase<EpiPlain, pg8::StaticOrder, true, true>(ldsL, g, S, E); \
            PH_END \
        } else { \
            PH_BEGIN \
                pg8::Gemm g{Hb, 1024, (const bf16*)(ws + WS_OWIN) + (size_t)li * 3072 * 1024, 1024, M, 3072, 1024, wave_s}; pg8::StaticOrder S; S.init(M, 3072, G, (int)blockIdx.x); \
                EpiOddIn E{Zb, Zb + (size_t)M * 1024}; \
                pg8::gemm_phase<EpiOddIn, pg8::StaticOrder, true, true>(ldsL, g, S, E); \
            PH_END \
            PH_BEGIN \
                conv_odd_phase(Zb, Zb + (size_t)M * 1024, CAT, a.o_cw + li * 31 * 1024, a.o_cb + li * 1024, a.o_lng + li * 1024, a.o_lnb + li * 1024, (char*)lds, G, wave_s); \
            PH_END \
            PH_BEGIN \
                pg8::Gemm g{CAT, 1024, (const bf16*)(ws + WS_OWOUT) + (size_t)li * 1024 * 1024, 1024, M, 1024, 1024, wave_s}; pg8::StaticOrder S; S.init(M, 1024, G, (int)blockIdx.x); \
                EpiPlain E{Hb, 1024}; \
                pg8::gemm_phase<EpiPlain, pg8::StaticOrder, true, true>(ldsL, g, S, E); \
            PH_END \
        } \
        PH_BEGIN \
            const float* xin = (layer == 0) ? a.x : a.out; \
            if (layer < 3) norm_phase<true, true>(xin, a.out, Hb, mod + (size_t)layer * 4 * 3072, a.post_g + layer * 1024, mod + (size_t)(layer + 1) * 4 * 3072, a.pre_g + (layer + 1) * 1024, G, wave_s); \
            else norm_phase<true, false>(xin, a.out, Hb, mod + (size_t)layer * 4 * 3072, a.post_g + layer * 1024, nullptr, nullptr, G, wave_s); \
        PH_END \
    } while (0)
    LAYER_BODY(0); LAYER_BODY(1); LAYER_BODY(2); LAYER_BODY(3);
#undef LAYER_BODY
#undef PH_BEGIN
#undef PH_END
}

constexpr int N_PHASES = 2 + 5 + 4 + 5 + 4;

extern "C" void kernel_launch(void* const* d_in, const int* in_sizes, int n_in, void* d_out, int out_size, void* d_ws, size_t ws_size, hipStream_t stream) {
    static int grid = 0;
    if (grid == 0) {
        if (n_in != 21 || in_sizes[0] != M * DM || out_size != M * DM || ws_size < WS_END) { fprintf(stderr, "kernel_launch: unexpected shapes (n_in %d, ws %zu)\n", n_in, ws_size); grid = -1; return; }
        int dev = 0, cus = 0, per_cu = 0;
        hipGetDevice(&dev); hipDeviceGetAttribute(&cus, hipDeviceAttributeMultiprocessorCount, dev);
        if (hipFuncSetAttribute((const void*)mk_fwd, hipFuncAttributeMaxDynamicSharedMemorySize, LDS_BYTES) != hipSuccess) { fprintf(stderr, "kernel_launch: hipFuncSetAttribute failed\n"); grid = -1; return; }
        if (hipOccupancyMaxActiveBlocksPerMultiprocessor(&per_cu, (const void*)mk_fwd, 512, LDS_BYTES) != hipSuccess || per_cu < 1) { fprintf(stderr, "kernel_launch: occupancy query says %d\n", per_cu); per_cu = 1; }
        (void)hipGetLastError();
        grid = cus;
        fprintf(stderr, "kernel_launch: cus %d per_cu %d grid %d\n", cus, per_cu, grid);
    }
    if (grid < 0) return;
    Args a{};
    a.x = (const float*)d_in[0]; a.c = (const float*)d_in[1]; a.pos = (const int*)d_in[2]; a.ada_w = (const float*)d_in[3]; a.ada_b = (const float*)d_in[4];
    a.pre_g = (const float*)d_in[5]; a.post_g = (const float*)d_in[6]; a.e_win = (const float*)d_in[7]; a.e_scw = (const float*)d_in[8]; a.e_scb = (const float*)d_in[9];
    a.e_qg = (const float*)d_in[10]; a.e_kvg = (const float*)d_in[11]; a.e_wuq = (const float*)d_in[12]; a.e_wukv = (const float*)d_in[13]; a.e_wout = (const float*)d_in[14];
    a.o_win = (const float*)d_in[15]; a.o_cw = (const float*)d_in[16]; a.o_cb = (const float*)d_in[17]; a.o_lng = (const float*)d_in[18]; a.o_lnb = (const float*)d_in[19]; a.o_wout = (const float*)d_in[20];
    a.out = (float*)d_out; a.ws = (unsigned char*)d_ws;
#if MK_ONE_LAUNCH
    a.ph_lo = 0; a.ph_hi = N_PHASES;
    void* args[] = {&a};
    hipError_t e = hipLaunchCooperativeKernel((const void*)mk_fwd, dim3(grid), dim3(512), args, LDS_BYTES, stream);
    if (e != hipSuccess) fprintf(stderr, "kernel_launch: cooperative launch failed: %s (grid %d)\n", hipGetErrorString(e), grid);
#else
    for (int p = 0; p < N_PHASES; ++p) { a.ph_lo = p; a.ph_hi = p + 1; hipLaunchKernelGGL(mk_fwd, dim3(grid), dim3(512), LDS_BYTES, stream, a); }
#endif
}
```

```cpp
#include <hip/hip_runtime.h>
#include <hip/hip_cooperative_groups.h>
#include <cstdio>
#include <cstdint>
namespace cg = cooperative_groups;

#ifndef MK_ONE_LAUNCH
#define MK_ONE_LAUNCH 1
#endif
#ifndef REP_P0
#define REP_P0 1
#endif
#ifndef REP_NORM0
#define REP_NORM0 1
#endif
#ifndef REP_GIN
#define REP_GIN 1
#endif
#ifndef REP_E2
#define REP_E2 1
#endif
#ifndef REP_ATT
#define REP_ATT 1
#endif
#ifndef REP_GOUT
#define REP_GOUT 1
#endif
#ifndef REP_CONV
#define REP_CONV 1
#endif
#ifndef REP_SYNC
#define REP_SYNC 1
#endif

namespace pg8 {
#define PG8_LAS __attribute__((address_space(3)))
typedef unsigned short bf16_t;
typedef short bf16x8 __attribute__((ext_vector_type(8)));
typedef float f32x4 __attribute__((ext_vector_type(4)));
typedef unsigned u32x4 __attribute__((ext_vector_type(4)));
constexpr int BM = 256, BK = 64, HALF = 128, HTB = HALF * BK * 2, STAGE_BYTES = 8 * HTB, NXCD = 8, WGM = 8;

__host__ __device__ __forceinline__ int lds_byte(int r, int c) { const int st = (r >> 4) * 2 + (c >> 5), rr = r & 15, cc = c & 31, ob = rr * 64 + cc * 2; return st * 1024 + (ob ^ (((ob >> 9) & 1) << 5)); }
__host__ __device__ __forceinline__ void stage_rc(int b, int& R, int& C) { const int st = b / 1024, sb = b % 1024, swz = sb ^ (((sb >> 9) & 1) << 5); R = (st >> 1) * 16 + swz / 64; C = (st & 1) * 32 + (swz % 64) / 2; }
__host__ __device__ __forceinline__ int perm32(int rho) { const int n = rho >> 4, i = rho & 15; return 8 * (i >> 2) + 4 * n + (i & 3); }

struct Unit { int pm, pn; };
struct Gemm { const bf16_t* A; int lda; const bf16_t* Bt; int ldb; int M, N, K; int wave; };

struct StaticOrder {
    int nM, nN, nwg, G, c;
    __host__ __device__ void init(int M, int N, int G_, int c_) { nM = M / BM; nN = N / BM; nwg = nM * nN; G = G_; c = c_; }
    __host__ __device__ bool next(int i, Unit& u) const {
        const long L = (long)i * G + c; if (L >= nwg) return false;
        int wgid = (int)L; { const int q = nwg / NXCD, r = nwg % NXCD, xcd = wgid % NXCD, off = wgid / NXCD; wgid = (xcd < r ? xcd * (q + 1) : r * (q + 1) + (xcd - r) * q) + off; }
        const int nig = WGM * nN, gid = wgid / nig, fm = gid * WGM, gsz = (nM - fm) < WGM ? (nM - fm) : WGM;
        u.pm = fm + ((wgid % nig) % gsz); u.pn = (wgid % nig) / gsz; return true;
    }
    __device__ __forceinline__ void a_ready(const Unit&) const {}
    __device__ __forceinline__ void done(const Unit&) const {}
};

__device__ __forceinline__ unsigned cvt_pk_bf16(float lo, float hi) { unsigned r; asm volatile("v_cvt_pk_bf16_f32 %0, %1, %2" : "=v"(r) : "v"(lo), "v"(hi)); return r;}

template <class Epi, class Sched, bool ALIGN_EPI = false, bool SP2 = false>
__device__ __forceinline__ void gemm_phase(PG8_LAS unsigned char* lds, const Gemm g, const Sched& S, const Epi& E) {
    int lane; asm volatile("v_mbcnt_lo_u32_b32 %0, -1, 0\n\tv_mbcnt_hi_u32_b32 %0, -1, %0" : "=v"(lane)); int wid = g.wave; asm volatile("" : "+s"(wid)); const int tid = wid * 64 + lane, wr = wid >> 2, wc = wid & 3, fr = lane & 15, fq = lane >> 4;
    const int K = g.K, nt = K / BK;
    unsigned voffA[2], voffB[2];
#pragma unroll
    for (int i = 0; i < 2; ++i) { int R, C; stage_rc(tid * 16 + i * 8192, R, C); const int Rb = Epi::PERM ? ((R & ~31) + perm32(R & 31)) : R;
        voffA[i] = (unsigned)(R * g.lda + C) * 2u; voffB[i] = (unsigned)(Rb * g.ldb + C) * 2u; }
    const size_t kstep = (size_t)(BK * 2);
    const size_t hstepA = (size_t)HALF * g.lda * 2, hstepB = (size_t)HALF * g.ldb * 2;
    const size_t tstepA = 2 * hstepA, tstepB = 2 * hstepB;
    const unsigned ldsw = (unsigned)wid * 1024u;
    const int aoff = lds_byte(wr * 64 + fr, fq * 8), boff = lds_byte(wc * 32 + fr, fq * 8);
#define PG8_SA(b, h) (((b) * 2 + (h)) * HTB)
#define PG8_SB(b, h) ((4 + (b) * 2 + (h)) * HTB)
#define PG8_STAGE(bufoff, gbase, voff) do { _Pragma("unroll") for (int _i = 0; _i < 2; ++_i) \
        __builtin_amdgcn_global_load_lds((const unsigned*)((const char*)(gbase) + (voff)[_i]), (PG8_LAS unsigned*)(lds + (bufoff) + ldsw + _i * 8192), 16, 0, 0); } while (0)
#define PG8_LDA(dst, b, h) do { _Pragma("unroll") for (int m = 0; m < 4; ++m) _Pragma("unroll") for (int k = 0; k < 2; ++k) dst[m][k] = *(const PG8_LAS bf16x8*)(lds + PG8_SA(b, h) + aoff + m * 2048 + k * 1024); } while (0)
#define PG8_LDB(dst, b, h) do { _Pragma("unroll") for (int n = 0; n < 2; ++n) _Pragma("unroll") for (int k = 0; k < 2; ++k) dst[n][k] = *(const PG8_LAS bf16x8*)(lds + PG8_SB(b, h) + boff + n * 2048 + k * 1024); } while (0)
#define PG8_MMA(ai, bj, At, Bt) do { __builtin_amdgcn_s_setprio(1); _Pragma("unroll") for (int m = 0; m < 4; ++m) _Pragma("unroll") for (int n = 0; n < 2; ++n) _Pragma("unroll") for (int k = 0; k < 2; ++k) \
        acc[ai][bj][m][n] = __builtin_amdgcn_mfma_f32_16x16x32_bf16(Bt[n][k], At[m][k], acc[ai][bj][m][n], 0, 0, 0); __builtin_amdgcn_s_setprio(0); } while (0)
#define PG8_WAIT_V(n) asm volatile("s_waitcnt vmcnt(" #n ")" ::: "memory")
#define PG8_WAIT_L(n) asm volatile("s_waitcnt lgkmcnt(" #n ")" ::: "memory")
#define PG8_BAR __builtin_amdgcn_s_barrier()
#define PG8_SCHED __builtin_amdgcn_sched_barrier(0)
    Unit cur, nxt; int ui = 0;
    if (!S.next(0, cur)) return;
    f32x4 acc[2][2][4][2];
#pragma unroll
    for (int a = 0; a < 2; ++a)
#pragma unroll
        for (int b = 0; b < 2; ++b)
#pragma unroll
            for (int m = 0; m < 4; ++m)
#pragma unroll
                for (int n = 0; n < 2; ++n) acc[a][b][m][n] = (f32x4){0.f, 0.f, 0.f, 0.f};
    bf16x8 At[4][2], B0[2][2], B1[2][2];
    const char* cA = (const char*)g.A + (size_t)cur.pm * tstepA; const char* cB = (const char*)g.Bt + (size_t)cur.pn * tstepB;
    S.a_ready(cur);
    if constexpr (SP2) {
        PG8_STAGE(PG8_SB(0, 0), cB, voffB); PG8_STAGE(PG8_SB(0, 1), cB + hstepB, voffB); PG8_STAGE(PG8_SA(0, 0), cA, voffA); PG8_STAGE(PG8_SA(0, 1), cA + hstepA, voffA);
        if (wr == 1) PG8_BAR;
        PG8_WAIT_V(2); PG8_BAR;
        PG8_STAGE(PG8_SB(1, 0), cB + kstep, voffB); PG8_STAGE(PG8_SA(1, 0), cA + kstep, voffA); PG8_STAGE(PG8_SB(1, 1), cB + hstepB + kstep, voffB);
        PG8_WAIT_V(6); PG8_BAR;
    } else {
        PG8_STAGE(PG8_SB(0, 0), cB, voffB); PG8_STAGE(PG8_SA(0, 0), cA, voffA); PG8_STAGE(PG8_SB(0, 1), cB + hstepB, voffB); PG8_STAGE(PG8_SA(0, 1), cA + hstepA, voffA);
        if (wr == 1) PG8_BAR;
        PG8_WAIT_V(4); PG8_BAR;
        PG8_STAGE(PG8_SB(1, 0), cB + kstep, voffB); PG8_STAGE(PG8_SA(1, 0), cA + kstep, voffA); PG8_STAGE(PG8_SB(1, 1), cB + hstepB + kstep, voffB);
        PG8_WAIT_V(6); PG8_BAR;
    }
    for (;;) {
        const bool has_next = S.next(ui + 1, nxt);
        const char* nA = has_next ? (const char*)g.A + (size_t)nxt.pm * tstepA : cA; const char* nB = has_next ? (const char*)g.Bt + (size_t)nxt.pn * tstepB : cB;
        for (int t = 0; t < nt; t += 2) {
            const bool last = (t == nt - 2);
            const char* a1 = cA + (size_t)(t + 1) * kstep;
            const char* a2 = last ? nA : cA + (size_t)(t + 2) * kstep; const char* b2 = last ? nB : cB + (size_t)(t + 2) * kstep;
            const char* a3 = a2 + kstep; const char* b3 = b2 + kstep;
            if (last && has_next) S.a_ready(nxt);
            if constexpr (SP2) {
            PG8_LDB(B0, 0, 0); PG8_LDB(B1, 0, 1); PG8_SCHED; PG8_LDA(At, 0, 0); PG8_STAGE(PG8_SA(1, 1), a1 + hstepA, voffA);
            PG8_WAIT_V(8); PG8_WAIT_L(0); PG8_BAR; PG8_MMA(0, 0, At, B0); PG8_MMA(0, 1, At, B1); PG8_BAR; PG8_SCHED;
            PG8_LDA(At, 0, 1); PG8_STAGE(PG8_SB(0, 0), b2, voffB); PG8_STAGE(PG8_SB(0, 1), b2 + hstepB, voffB); PG8_STAGE(PG8_SA(0, 0), a2, voffA);
            PG8_WAIT_V(8); PG8_WAIT_L(0); PG8_BAR; PG8_MMA(1, 0, At, B0); PG8_MMA(1, 1, At, B1); PG8_BAR; PG8_SCHED;
            PG8_LDB(B0, 1, 0); PG8_LDB(B1, 1, 1); PG8_SCHED; PG8_LDA(At, 1, 0); PG8_STAGE(PG8_SA(0, 1), a2 + hstepA, voffA);
            PG8_WAIT_V(8); PG8_WAIT_L(0); PG8_BAR; PG8_MMA(0, 0, At, B0); PG8_MMA(0, 1, At, B1); PG8_BAR; PG8_SCHED;
            PG8_LDA(At, 1, 1); PG8_STAGE(PG8_SB(1, 0), b3, voffB); PG8_STAGE(PG8_SB(1, 1), b3 + hstepB, voffB); PG8_STAGE(PG8_SA(1, 0), a3, voffA);
            PG8_WAIT_V(8); PG8_WAIT_L(0); PG8_BAR; PG8_MMA(1, 0, At, B0); PG8_MMA(1, 1, At, B1); PG8_BAR; PG8_SCHED;
            } else {
            PG8_LDB(B0, 0, 0); PG8_SCHED; PG8_LDA(At, 0, 0); PG8_STAGE(PG8_SA(1, 1), a1 + hstepA, voffA);
            PG8_WAIT_L(8); PG8_BAR; PG8_WAIT_L(0); PG8_MMA(0, 0, At, B0); PG8_BAR; PG8_SCHED;
            PG8_LDB(B1, 0, 1); PG8_STAGE(PG8_SB(0, 0), b2, voffB);
            PG8_BAR; PG8_WAIT_L(0); PG8_MMA(0, 1, At, B1); PG8_BAR;
            PG8_LDA(At, 0, 1); PG8_STAGE(PG8_SA(0, 0), a2, voffA);
            PG8_BAR; PG8_WAIT_L(0); PG8_MMA(1, 0, At, B0); PG8_BAR; PG8_SCHED;
            PG8_STAGE(PG8_SB(0, 1), b2 + hstepB, voffB);
            PG8_WAIT_V(6); PG8_BAR; PG8_MMA(1, 1, At, B1); PG8_BAR;
            PG8_LDB(B0, 1, 0); PG8_SCHED; PG8_LDA(At, 1, 0); PG8_STAGE(PG8_SA(0, 1), a2 + hstepA, voffA);
            PG8_WAIT_L(8); PG8_BAR; PG8_WAIT_L(0); PG8_MMA(0, 0, At, B0); PG8_BAR; PG8_SCHED;
            PG8_LDB(B1, 1, 1); PG8_STAGE(PG8_SB(1, 0), b3, voffB);
            PG8_BAR; PG8_WAIT_L(0); PG8_MMA(0, 1, At, B1); PG8_BAR;
            PG8_LDA(At, 1, 1); PG8_STAGE(PG8_SA(1, 0), a3, voffA);
            PG8_BAR; PG8_WAIT_L(0); PG8_MMA(1, 0, At, B0); PG8_BAR; PG8_SCHED;
            PG8_STAGE(PG8_SB(1, 1), b3 + hstepB, voffB);
            PG8_WAIT_V(6); PG8_BAR; PG8_MMA(1, 1, At, B1); PG8_BAR;
            }
        }
        if constexpr (ALIGN_EPI) { if (wr == 0) PG8_BAR; }
        E(acc, cur, wr, wc, fr, fq); S.done(cur);
        if (!has_next) break;
#pragma unroll
        for (int a = 0; a < 2; ++a)
#pragma unroll
            for (int b = 0; b < 2; ++b)
#pragma unroll
                for (int m = 0; m < 4; ++m)
#pragma unroll
                    for (int n = 0; n < 2; ++n) acc[a][b][m][n] = (f32x4){0.f, 0.f, 0.f, 0.f};
        cur = nxt; cA = nA; cB = nB; ++ui;
        if constexpr (ALIGN_EPI) { if (wr == 1) PG8_BAR; }
    }
    PG8_WAIT_V(0);
    if constexpr (!ALIGN_EPI) { if (wr == 0) PG8_BAR; }
    PG8_BAR;
#undef PG8_SA
#undef PG8_SB
#undef PG8_STAGE
#undef PG8_LDA
#undef PG8_LDB
#undef PG8_MMA
#undef PG8_WAIT_V
#undef PG8_WAIT_L
#undef PG8_BAR
#undef PG8_SCHED
}
}

typedef unsigned short bf16;
typedef short bf16x8 __attribute__((ext_vector_type(8)));
typedef short s16x4 __attribute__((ext_vector_type(4)));
typedef float f32x4 __attribute__((ext_vector_type(4)));
typedef float f32x16 __attribute__((ext_vector_type(16)));
typedef unsigned u32x4 __attribute__((ext_vector_type(4)));
typedef unsigned u32x2 __attribute__((ext_vector_type(2)));
#define LAS __attribute__((address_space(3)))

constexpr int M = 16384, DM = 1024, SEQ = 4096, NBATCH = 4;
constexpr int EVEN_IN = 2976, ZLD = 3072;
constexpr int COL_CQ = 2048, COL_CKV = 2304, COL_KR = 2432, COL_BG = 2464;
constexpr float EPS = 1e-6f;
constexpr size_t MiB = 1u << 20;
constexpr size_t WS_MOD = 1 * MiB;
constexpr size_t WS_SSQ_Q = 1 * MiB + 256 * 1024;
constexpr size_t WS_SSQ_KV = 1 * MiB + 512 * 1024;
constexpr size_t WS_COS = 2 * MiB, WS_SIN = 3 * MiB;
constexpr size_t WS_KR = 4 * MiB;
constexpr size_t WS_EWIN = 6 * MiB;
constexpr size_t WS_OWIN = 18 * MiB;
constexpr size_t WS_EWOUT = 30 * MiB;
constexpr size_t WS_OWOUT = 34 * MiB;
constexpr size_t WS_WUQ = 38 * MiB;
constexpr size_t WS_WUKV = 39 * MiB;
constexpr size_t WS_H = 40 * MiB;
constexpr size_t WS_Z = 72 * MiB;
constexpr size_t WS_KV = 168 * MiB;
constexpr size_t WS_CAT = 200 * MiB;
constexpr size_t WS_END = 232 * MiB;
constexpr int LDS_BYTES = 147456;

__device__ __forceinline__ unsigned cvtpk(float lo, float hi) { unsigned r; asm volatile("v_cvt_pk_bf16_f32 %0, %1, %2" : "=v"(r) : "v"(lo), "v"(hi)); return r; }
__device__ __forceinline__ float bflo(unsigned w) { return __uint_as_float(w << 16); }
__device__ __forceinline__ float bfhi(unsigned w) { return __uint_as_float(w & 0xffff0000u); }
__device__ __forceinline__ float sigmoidf_(float x) { return 1.f / (1.f + __expf(-x)); }
__device__ __forceinline__ float siluf_(float x) { return x / (1.f + __expf(-x)); }
__device__ __forceinline__ int opaque_tid(int wave_s) { int l; asm volatile("v_mbcnt_lo_u32_b32 %0, -1, 0\n\tv_mbcnt_hi_u32_b32 %0, -1, %0" : "=v"(l)); asm volatile("" : "+s"(wave_s)); return wave_s * 64 + l; }
__device__ __forceinline__ float wave_sum(float v) {
#pragma unroll
    for (int o = 1; o < 64; o <<= 1) v += __shfl_xor(v, o);
    return v;
}


#define XB_TMO      128
#define XB_XCNT(j)  (256  + 64 * (j))
#define XB_XSUB(j)  (1280 + 64 * (j))
#define XB_XGEN(j)  (2304 + 64 * (j))
#define XB_TOP      3328
#define XB_TOPGEN   3392
#define XCD_BAR_WORDS 3456
#define XB_SPIN_CAP (1u << 18)
__device__ __forceinline__ unsigned xb_ld(unsigned* p)              { return __hip_atomic_load(p, __ATOMIC_RELAXED, __HIP_MEMORY_SCOPE_AGENT); }
__device__ __forceinline__ unsigned xb_add(unsigned* p, unsigned v) { return __hip_atomic_fetch_add(p, v, __ATOMIC_RELAXED, __HIP_MEMORY_SCOPE_AGENT); }
__device__ __forceinline__ unsigned xb_xcc_id() { return (unsigned)__builtin_amdgcn_s_getreg((3 << 11) | 20) & 0xFu; }
#define XB_SPIN(cond, bar) do { unsigned _sp = 0; while (cond) { __builtin_amdgcn_s_sleep(1); \
    if ((++_sp & 255u) == 0u) { if (xb_ld(&(bar)[XB_TMO])) break; if (_sp > XB_SPIN_CAP) { atomicAdd(&(bar)[XB_TMO], 1u); break; } } } } while (0)
struct XcdBarrier { unsigned* bar; unsigned x; volatile LAS unsigned* st; };
__device__ __forceinline__ XcdBarrier xcd_barrier_post(unsigned* bar, volatile LAS unsigned* st) {
    XcdBarrier b; b.bar = bar; b.x = xb_xcc_id(); b.st = st;
    if (threadIdx.x == 0) (void)xb_add(&bar[XB_XCNT(b.x)], 1u);
    return b;
}
__device__ __forceinline__ void xcd_barrier_complete(unsigned* bar, unsigned x, unsigned& nloc, unsigned& nx) {
    const unsigned G = gridDim.x * gridDim.y * gridDim.z;
    unsigned sum, cnt, mine, sp = 0u;
    for (;;) {
        sum = 0u; cnt = 0u; mine = 0u;
#pragma unroll
        for (unsigned j = 0; j < 16; ++j) { const unsigned c = xb_ld(&bar[XB_XCNT(j)]); sum += c; cnt += (c > 0u) ? 1u : 0u; mine = (j == x) ? c : mine; }
        if (sum == G) break;
        __builtin_amdgcn_s_sleep(1);
        if ((++sp & 255u) == 0u) { if (xb_ld(&bar[XB_TMO])) break; if (sp > XB_SPIN_CAP) { atomicAdd(&bar[XB_TMO], 1u); break; } }
    }
    nloc = mine > 0u ? mine : 1u; nx = cnt > 0u ? cnt : 1u;
}
__device__ __forceinline__ void xcd_barrier(const XcdBarrier& b) {
    asm volatile("s_waitcnt vmcnt(0)" ::: "memory");
    __syncthreads();
    if (threadIdx.x == 0) {
        unsigned* bar = b.bar;
        __builtin_amdgcn_s_waitcnt(0);
        unsigned nloc = b.st[0], nx = b.st[1];
        if (nloc == 0u) { xcd_barrier_complete(bar, b.x, nloc, nx); b.st[0] = nloc; b.st[1] = nx; }
        const unsigned old = xb_add(&bar[XB_XSUB(b.x)], 1u);
        const unsigned gen = old / nloc;
        if (old + 1u == (gen + 1u) * nloc) {
            __builtin_amdgcn_fence(__ATOMIC_RELEASE, "agent");
            asm volatile("s_waitcnt vmcnt(0)" ::: "memory");
            const unsigned og = xb_add(&bar[XB_TOP], 1u);
            const unsigned tg = og / nx;
            if (og + 1u == (tg + 1u) * nx) xb_add(&bar[XB_TOPGEN], 1u);
            else XB_SPIN(xb_ld(&bar[XB_TOPGEN]) == tg, bar);
            __builtin_amdgcn_fence(__ATOMIC_ACQUIRE, "agent");
            xb_add(&bar[XB_XGEN(b.x)], 1u);
            asm volatile("s_waitcnt vmcnt(0)" ::: "memory");
        } else {
            XB_SPIN(xb_ld(&bar[XB_XGEN(b.x)]) == gen, bar);
            __builtin_amdgcn_fence(__ATOMIC_ACQUIRE, "agent");
            asm volatile("s_waitcnt vmcnt(0)" ::: "memory");
        }
    }
    __syncthreads();
}

using pg8::Unit;
struct EpiEvenIn {
    static constexpr bool PERM = true, AFTER_DRAIN = false;
    bf16* Z; float* ssq_q; float* ssq_kv;
    __device__ __forceinline__ void operator()(const f32x4 (&acc)[2][2][4][2], const Unit& u, int wr, int wc, int fr, int fq) const {
        const int row0 = u.pm * 256 + wr * 64 + fr, col0 = u.pn * 256 + wc * 32 + 8 * fq;
#pragma unroll
        for (int ai = 0; ai < 2; ++ai)
#pragma unroll
            for (int m = 0; m < 4; ++m) { bf16* rowp = Z + (size_t)(row0 + ai * 128 + m * 16) * ZLD + col0;
#pragma unroll
                for (int bj = 0; bj < 2; ++bj) { const f32x4 v0 = acc[ai][bj][m][0], v1 = acc[ai][bj][m][1];
                    u32x4 w; w.x = cvtpk(v0[0], v0[1]); w.y = cvtpk(v0[2], v0[3]); w.z = cvtpk(v1[0], v1[1]); w.w = cvtpk(v1[2], v1[3]);
                    *(u32x4*)(rowp + bj * 128) = w; } }
        if (u.pn == 8 || u.pn == 9) {
            float* dst = (u.pn == 8) ? ssq_q : ssq_kv; const int nbj = (u.pn == 8) ? 2 : 1;
#pragma unroll
            for (int ai = 0; ai < 2; ++ai)
#pragma unroll
                for (int m = 0; m < 4; ++m) { float s = 0.f;
#pragma unroll
                    for (int bj = 0; bj < 2; ++bj) if (bj < nbj)
#pragma unroll
                        for (int n = 0; n < 2; ++n) { const f32x4 x = acc[ai][bj][m][n]; s += (x[0] * x[0] + x[1] * x[1]) + (x[2] * x[2] + x[3] * x[3]); }
                    s += __shfl_xor(s, 16); s += __shfl_xor(s, 32);
                    if (fq == 0) dst[(size_t)(row0 + ai * 128 + m * 16) * 4 + wc] = s; }
        }
    }
};
struct EpiQ {
    static constexpr bool PERM = true, AFTER_DRAIN = false;
    bf16* Q; const float* ssq_q;
    __device__ __forceinline__ void operator()(const f32x4 (&acc)[2][2][4][2], const Unit& u, int wr, int wc, int fr, int fq) const {
        const int row0 = u.pm * 256 + wr * 64 + fr, col0 = u.pn * 256 + wc * 32 + 8 * fq;
#pragma unroll
        for (int ai = 0; ai < 2; ++ai)
#pragma unroll
            for (int m = 0; m < 4; ++m) { const int row = row0 + ai * 128 + m * 16;
                const f32x4 pq = *(const f32x4*)(ssq_q + (size_t)row * 4);
                const float rstd = rsqrtf(((pq[0] + pq[1]) + (pq[2] + pq[3])) * (1.f / 256.f) + EPS);
#pragma unroll
                for (int bj = 0; bj < 2; ++bj) {
                    f32x4 v0 = acc[ai][bj][m][0] * rstd, v1 = acc[ai][bj][m][1] * rstd;
                    u32x4 w; w.x = cvtpk(v0[0], v0[1]); w.y = cvtpk(v0[2], v0[3]); w.z = cvtpk(v1[0], v1[1]); w.w = cvtpk(v1[2], v1[3]);
                    *(u32x4*)(Q + (size_t)row * 768 + col0 + bj * 128) = w; } }
    }
};
struct EpiKV {
    static constexpr bool PERM = true, AFTER_DRAIN = false;
    bf16* KV; const float* ssq_kv;
    __device__ __forceinline__ void operator()(const f32x4 (&acc)[2][2][4][2], const Unit& u, int wr, int wc, int fr, int fq) const {
        const int row0 = u.pm * 256 + wr * 64 + fr, col0 = u.pn * 256 + wc * 32 + 8 * fq;
#pragma unroll
        for (int ai = 0; ai < 2; ++ai)
#pragma unroll
            for (int m = 0; m < 4; ++m) { const int row = row0 + ai * 128 + m * 16;
                const f32x4 pq = *(const f32x4*)(ssq_kv + (size_t)row * 4);
                const float rstd = rsqrtf(((pq[0] + pq[1]) + (pq[2] + pq[3])) * (1.f / 128.f) + EPS);
#pragma unroll
                for (int bj = 0; bj < 2; ++bj) { const f32x4 v0 = acc[ai][bj][m][0] * rstd, v1 = acc[ai][bj][m][1] * rstd;
                    u32x4 w; w.x = cvtpk(v0[0], v0[1]); w.y = cvtpk(v0[2], v0[3]); w.z = cvtpk(v1[0], v1[1]); w.w = cvtpk(v1[2], v1[3]);
                    *(u32x4*)(KV + (size_t)row * 1024 + col0 + bj * 128) = w; } }
    }
};
struct EpiPlain {
    static constexpr bool PERM = true, AFTER_DRAIN = false;
    bf16* O; int ldc;
    __device__ __forceinline__ void operator()(const f32x4 (&acc)[2][2][4][2], const Unit& u, int wr, int wc, int fr, int fq) const {
        const int row0 = u.pm * 256 + wr * 64 + fr, col0 = u.pn * 256 + wc * 32 + 8 * fq;
#pragma unroll
        for (int ai = 0; ai < 2; ++ai)
#pragma unroll
            for (int m = 0; m < 4; ++m) { bf16* rowp = O + (size_t)(row0 + ai * 128 + m * 16) * ldc + col0;
#pragma unroll
                for (int bj = 0; bj < 2; ++bj) { const f32x4 v0 = acc[ai][bj][m][0], v1 = acc[ai][bj][m][1];
                    u32x4 w; w.x = cvtpk(v0[0], v0[1]); w.y = cvtpk(v0[2], v0[3]); w.z = cvtpk(v1[0], v1[1]); w.w = cvtpk(v1[2], v1[3]);
                    *(u32x4*)(rowp + bj * 128) = w; } }
    }
};
struct EpiOddIn {
    static constexpr bool PERM = true, AFTER_DRAIN = false;
    bf16* U; bf16* SG;
    __device__ __forceinline__ void operator()(const f32x4 (&acc)[2][2][4][2], const Unit& u, int wr, int wc, int fr, int fq) const {
        const int row0 = u.pm * 256 + wr * 64 + fr;
        if (u.pn < 8) {
            const int col0 = u.pn * 128 + wc * 32 + 8 * fq;
#pragma unroll
            for (int ai = 0; ai < 2; ++ai)
#pragma unroll
                for (int m = 0; m < 4; ++m) { f32x4 v0 = acc[ai][0][m][0], v1 = acc[ai][0][m][1]; const f32x4 g0 = acc[ai][1][m][0], g1 = acc[ai][1][m][1];
#pragma unroll
                    for (int j = 0; j < 4; ++j) { v0[j] *= sigmoidf_(g0[j]); v1[j] *= sigmoidf_(g1[j]); }
                    u32x4 w; w.x = cvtpk(v0[0], v0[1]); w.y = cvtpk(v0[2], v0[3]); w.z = cvtpk(v1[0], v1[1]); w.w = cvtpk(v1[2], v1[3]);
                    *(u32x4*)(U + (size_t)(row0 + ai * 128 + m * 16) * 1024 + col0) = w; }
        } else {
            const int col0 = (u.pn - 8) * 256 + wc * 32 + 8 * fq;
#pragma unroll
            for (int ai = 0; ai < 2; ++ai)
#pragma unroll
                for (int m = 0; m < 4; ++m)
#pragma unroll
                    for (int bj = 0; bj < 2; ++bj) { f32x4 v0 = acc[ai][bj][m][0], v1 = acc[ai][bj][m][1];
#pragma unroll
                        for (int j = 0; j < 4; ++j) { v0[j] = siluf_(v0[j]); v1[j] = siluf_(v1[j]); }
                        u32x4 w; w.x = cvtpk(v0[0], v0[1]); w.y = cvtpk(v0[2], v0[3]); w.z = cvtpk(v1[0], v1[1]); w.w = cvtpk(v1[2], v1[3]);
                        *(u32x4*)(SG + (size_t)(row0 + ai * 128 + m * 16) * 1024 + col0 + bj * 128) = w; }
        }
    }
};

namespace att {
constexpr float SCALE = 0.10206207261596577f;
constexpr float THR = 8.f;
constexpr int SHM_V = 64 * 64 * 2, SHM_K = 64 * 256;
#define KSWZ(row, colB) ((row) * 256 + ((colB) ^ (((row) & 7) << 4)))
#define SBAR() __builtin_amdgcn_sched_barrier(0)
__device__ __forceinline__ int crow(int r, int hi) { return (r & 3) + 8 * (r >> 2) + 4 * hi; }
__device__ __forceinline__ void partialSM(f32x16& p0, f32x16& p1, float& m_reg, float& mn, float& alpha) {
    constexpr float C = SCALE * 1.4426950408889634f;
    float pmax = p0[0];
#pragma unroll
    for (int r = 1; r < 16; ++r) pmax = fmaxf(pmax, p0[r]);
#pragma unroll
    for (int r = 0; r < 16; ++r) pmax = fmaxf(pmax, p1[r]);
    { auto rr = __builtin_amdgcn_permlane32_swap(__float_as_uint(pmax), __float_as_uint(pmax), false, false);
      pmax = fmaxf(__uint_as_float(rr[0]), __uint_as_float(rr[1])); }
    if (__builtin_expect(__all(pmax - m_reg <= THR / SCALE), 1)) { mn = m_reg; alpha = 1.f; }
    else { mn = fmaxf(m_reg, pmax); alpha = __builtin_amdgcn_exp2f((m_reg - mn) * C); m_reg = mn; }
    const float mnC = -mn * C;
#pragma unroll
    for (int r = 0; r < 16; ++r) p0[r] = fmaf(p0[r], C, mnC);
#pragma unroll
    for (int r = 0; r < 16; ++r) p1[r] = fmaf(p1[r], C, mnC);
#pragma unroll
    for (int r = 0; r < 16; ++r) p0[r] = __builtin_amdgcn_exp2f(p0[r]);
}
__device__ __forceinline__ void finishSM(f32x16& p0, f32x16& p1, float alpha, float& l_reg, bf16x8& pa0, bf16x8& pa1, bf16x8& pa2, bf16x8& pa3) {
#pragma unroll
    for (int r = 0; r < 16; ++r) p1[r] = __builtin_amdgcn_exp2f(p1[r]);
    float ps = 0;
#pragma unroll
    for (int r = 0; r < 16; ++r) ps += p0[r];
#pragma unroll
    for (int r = 0; r < 16; ++r) ps += p1[r];
    { auto rr = __builtin_amdgcn_permlane32_swap(__float_as_uint(ps), __float_as_uint(ps), false, false);
      ps = __uint_as_float(rr[0]) + __uint_as_float(rr[1]); }
    l_reg = l_reg * alpha + ps;
#define PK4(P, BASE, OUT) do { unsigned a0 = cvtpk(P[BASE + 0], P[BASE + 1]), a1 = cvtpk(P[BASE + 2], P[BASE + 3]);   \
    unsigned b0 = cvtpk(P[BASE + 4], P[BASE + 5]), b1 = cvtpk(P[BASE + 6], P[BASE + 7]);                              \
    auto r0 = __builtin_amdgcn_permlane32_swap(a0, b0, false, false); auto r1 = __builtin_amdgcn_permlane32_swap(a1, b1, false, false); \
    u32x4 w = {r0[0], r1[0], r0[1], r1[1]}; OUT = *reinterpret_cast<bf16x8*>(&w); } while (0)
    PK4(p0, 0, pa0); PK4(p0, 8, pa1); PK4(p1, 0, pa2); PK4(p1, 8, pa3);
#undef PK4
}
__device__ __forceinline__ void qkt(f32x16& p0, f32x16& p1, const char* Ks, const bf16x8* qr, int r32, int hi, bool active) {
    if (active) {
        p0 = f32x16{}; p1 = f32x16{};
#pragma unroll
        for (int d0 = 0; d0 < 6; ++d0) { const int cb = (d0 * 16 + hi * 8) * 2;
            const bf16x8 b0 = *reinterpret_cast<const bf16x8*>(Ks + KSWZ(r32, cb));
            const bf16x8 b1 = *reinterpret_cast<const bf16x8*>(Ks + KSWZ(32 + r32, cb));
            p0 = __builtin_amdgcn_mfma_f32_32x32x16_bf16(b0, qr[d0], p0, 0, 0, 0);
            p1 = __builtin_amdgcn_mfma_f32_32x32x16_bf16(b1, qr[d0], p1, 0, 0, 0); }
    } else {
#pragma unroll
        for (int r = 0; r < 16; ++r) { p0[r] = -1e30f; p1[r] = -1e30f; }
    }
}
__device__ __forceinline__ int v_st(int k, int c) { const int kk = (k & ~0xC) | ((k & 4) << 1) | ((k & 8) >> 1); return ((kk >> 3) * 2 + (c >> 5)) * 512 + ((kk & 7) * 32 + (c & 31)) * 2; }
__device__ __forceinline__ int v_rd_base(int lane) { return ((lane & 3) << 3) | (((lane >> 2) & 3) << 6) | (((lane >> 4) & 1) << 5) | (((lane >> 5) & 1) << 8); }
constexpr int v_rd_off(int d0, int ks, int half) { return d0 * 512 + ks * 2048 + half * 1024; }
template <int OFF> __device__ __forceinline__ s16x4 tr_read(int vb) {
    s16x4 r; asm volatile("ds_read_b64_tr_b16 %0, %1 offset:%2" : "=&v"(r) : "v"(vb), "i"(OFF) : "memory"); return r;
}
template <int D0> __device__ __forceinline__ void pv_one(f32x16& od, int vb, bf16x8 pa0, bf16x8 pa1, bf16x8 pa2, bf16x8 pa3) {
    const s16x4 l0 = tr_read<v_rd_off(D0, 0, 0)>(vb), h0 = tr_read<v_rd_off(D0, 0, 1)>(vb), l1 = tr_read<v_rd_off(D0, 1, 0)>(vb), h1 = tr_read<v_rd_off(D0, 1, 1)>(vb);
    const s16x4 l2 = tr_read<v_rd_off(D0, 2, 0)>(vb), h2 = tr_read<v_rd_off(D0, 2, 1)>(vb), l3 = tr_read<v_rd_off(D0, 3, 0)>(vb), h3 = tr_read<v_rd_off(D0, 3, 1)>(vb);
    asm volatile("s_waitcnt lgkmcnt(0)" ::: "memory"); SBAR();
#define PK(L, H) (bf16x8){L[0], L[1], L[2], L[3], H[0], H[1], H[2], H[3]}
    od = __builtin_amdgcn_mfma_f32_32x32x16_bf16(pa0, PK(l0, h0), od, 0, 0, 0);
    od = __builtin_amdgcn_mfma_f32_32x32x16_bf16(pa1, PK(l1, h1), od, 0, 0, 0);
    od = __builtin_amdgcn_mfma_f32_32x32x16_bf16(pa2, PK(l2, h2), od, 0, 0, 0);
    od = __builtin_amdgcn_mfma_f32_32x32x16_bf16(pa3, PK(l3, h3), od, 0, 0, 0);
#undef PK
}
__device__ __forceinline__ void pv_d0(f32x16* o, int vb, bf16x8 pa0, bf16x8 pa1, bf16x8 pa2, bf16x8 pa3) {
    pv_one<0>(o[0], vb, pa0, pa1, pa2, pa3); pv_one<1>(o[1], vb, pa0, pa1, pa2, pa3);
}

__device__ __forceinline__ void attn_unit(int b, int h, int qb, const bf16* __restrict__ Q, const bf16* __restrict__ KV, const bf16* __restrict__ KR,
                                          const bf16* __restrict__ Z, bf16* __restrict__ CAT, const float* __restrict__ cosT, const float* __restrict__ sinT, char* lds, int wave_s) {
    const int tid = opaque_tid(wave_s), wid = tid >> 6, lane = tid & 63, r32 = lane & 31, hi = lane >> 5;
    char* V_lds = lds; char* K_lds = lds + 2 * SHM_V;
    float* ws = (float*)(lds + 2 * SHM_V + 2 * SHM_K) + wid * 64; float* li_l = ws; float* al_l = ws + 32;
    float m_reg = -1e30f, l_reg = 0; f32x16 o[2] = {}; bf16x8 qr[6];
    const long rowbase = (long)b * SEQ; const int q0 = qb * 256;
    const bf16* Qw = Q + (rowbase + q0 + wid * 32 + r32) * 768 + h * 96 + hi * 8;
#pragma unroll
    for (int d0 = 0; d0 < 6; ++d0) qr[d0] = *reinterpret_cast<const bf16x8*>(Qw + d0 * 16);
    {
        const size_t qrow = (size_t)(rowbase + q0 + wid * 32 + r32);
        const f32x4 c0 = *(const f32x4*)(cosT + qrow * 16 + 8 * hi), c1 = *(const f32x4*)(cosT + qrow * 16 + 8 * hi + 4);
        const f32x4 s0 = *(const f32x4*)(sinT + qrow * 16 + 8 * hi), s1 = *(const f32x4*)(sinT + qrow * 16 + 8 * hi + 4);
        const u32x4 t1w = __builtin_bit_cast(u32x4, qr[4]), t2w = __builtin_bit_cast(u32x4, qr[5]); u32x4 o1, o2;
#pragma unroll
        for (int q = 0; q < 4; ++q) { const float cl = q < 2 ? c0[2 * q] : c1[2 * q - 4], ch = q < 2 ? c0[2 * q + 1] : c1[2 * q - 3];
            const float sl = q < 2 ? s0[2 * q] : s1[2 * q - 4], sh = q < 2 ? s0[2 * q + 1] : s1[2 * q - 3];
            const float a_lo = bflo(t1w[q]), a_hi = bfhi(t1w[q]), b_lo = bflo(t2w[q]), b_hi = bfhi(t2w[q]);
            o1[q] = cvtpk(a_lo * cl - b_lo * sl, a_hi * ch - b_hi * sh); o2[q] = cvtpk(b_lo * cl + a_lo * sl, b_hi * ch + a_hi * sh); }
        qr[4] = __builtin_bit_cast(bf16x8, o1); qr[5] = __builtin_bit_cast(bf16x8, o2);
    }
    const int sr = tid >> 3, sc = (tid & 7) * 8, sr2 = (tid & 255) >> 2, sc2 = (tid & 3) * 8;
    const int vst = v_st(sr, sc), kst = KSWZ(sr, sc * 2), kst2 = KSWZ(sr2, (64 + sc2) * 2);
    const bf16* kvsrc = KV + (rowbase + sr) * 1024 + h * 128 + sc;
    const bf16* krsrc = KR + (rowbase + sr2) * 32 + sc2;
    const int vb0 = (int)(uintptr_t)V_lds + v_rd_base(lane);
    struct { bf16x8 kn, vv, kr; } sr_[2];
#define SLOAD(i, k0) do { sr_[i].kn = *reinterpret_cast<const bf16x8*>(kvsrc + (long)(k0) * 1024); sr_[i].vv = *reinterpret_cast<const bf16x8*>(kvsrc + (long)(k0) * 1024 + 64); \
    sr_[i].kr = *reinterpret_cast<const bf16x8*>(krsrc + (long)(k0) * 32); } while (0)
#define SWRITE(bb, i) do { *(bf16x8*)(V_lds + (bb) * SHM_V + vst) = sr_[i].vv; *(bf16x8*)(K_lds + (bb) * SHM_K + kst) = sr_[i].kn; *(bf16x8*)(K_lds + (bb) * SHM_K + kst2) = sr_[i].kr; } while (0)
#define SWAIT() asm volatile("s_waitcnt vmcnt(3)" ::: "memory")
#define RESC(a) do { if (__any((a) < 1.f)) { if (hi == 0) al_l[r32] = (a); asm volatile("s_waitcnt lgkmcnt(0)" ::: "memory"); \
    _Pragma("unroll") for (int d = 0; d < 2; ++d) _Pragma("unroll") for (int r = 0; r < 16; ++r) o[d][r] *= al_l[crow(r, hi)]; } } while (0)
    f32x16 pA0, pA1, pB0, pB1; float mnA, mnB, alA, alB; bf16x8 pa0, pa1, pa2, pa3;
    const int NT = q0 / 64 + 4, jmax = q0 / 64 + (wid >> 1);
    SLOAD(0, 0); asm volatile("s_waitcnt vmcnt(0)" ::: "memory"); SWRITE(0, 0); __syncthreads();
    qkt(pA0, pA1, K_lds, qr, r32, hi, true); partialSM(pA0, pA1, m_reg, mnA, alA);
    SLOAD(1, 64); if (2 < NT) SLOAD(0, 128);
    SWAIT(); SWRITE(1, 1); __syncthreads();
    for (int j = 1; j + 1 < NT; j += 2) {
        SBAR(); qkt(pB0, pB1, K_lds + SHM_K, qr, r32, hi, j <= jmax);
        finishSM(pA0, pA1, alA, l_reg, pa0, pa1, pa2, pa3); SBAR();
        SLOAD(1, (j + 2) * 64); SBAR();
        pv_d0(o, vb0, pa0, pa1, pa2, pa3); partialSM(pB0, pB1, m_reg, mnB, alB);
        __syncthreads(); SWAIT(); SWRITE(0, 0);
        RESC(alB); __syncthreads();
        SBAR(); qkt(pA0, pA1, K_lds, qr, r32, hi, j + 1 <= jmax);
        finishSM(pB0, pB1, alB, l_reg, pa0, pa1, pa2, pa3); SBAR();
        if (j + 3 < NT) SLOAD(0, (j + 3) * 64); SBAR();
        pv_d0(o, vb0 + SHM_V, pa0, pa1, pa2, pa3); partialSM(pA0, pA1, m_reg, mnA, alA);
        __syncthreads(); SWAIT(); SWRITE(1, 1);
        RESC(alA); __syncthreads();
    }
    SBAR(); qkt(pB0, pB1, K_lds + SHM_K, qr, r32, hi, NT - 1 <= jmax);
    finishSM(pA0, pA1, alA, l_reg, pa0, pa1, pa2, pa3); SBAR();
    pv_d0(o, vb0, pa0, pa1, pa2, pa3); partialSM(pB0, pB1, m_reg, mnB, alB);
    __syncthreads(); RESC(alB);
    finishSM(pB0, pB1, alB, l_reg, pa0, pa1, pa2, pa3); SBAR();
    pv_d0(o, vb0 + SHM_V, pa0, pa1, pa2, pa3);
    if (hi == 0) li_l[r32] = l_reg; asm volatile("s_waitcnt lgkmcnt(0)" ::: "memory");
    float rli[16];
#pragma unroll
    for (int r = 0; r < 16; ++r) rli[r] = __builtin_amdgcn_rcpf(li_l[crow(r, hi)]);
    const long orow0 = rowbase + q0 + wid * 32;
#pragma unroll
    for (int r = 0; r < 16; ++r) { const long row = orow0 + crow(r, hi);
#pragma unroll
        for (int d0 = 0; d0 < 2; ++d0) { const float gz = bflo((unsigned)Z[row * ZLD + COL_BG + h * 64 + d0 * 32 + r32]);
            const float v = o[d0][r] * rli[r] * siluf_(gz);
            CAT[row * 1024 + 512 + h * 64 + d0 * 32 + r32] = (bf16)(cvtpk(v, v) & 0xffffu); } }
    __syncthreads();
#undef SLOAD
#undef SWRITE
#undef SWAIT
#undef RESC
}
#undef SBAR
}

struct Args {
    const float* x; const float* c; const int* pos; const float* ada_w; const float* ada_b; const float* pre_g; const float* post_g;
    const float* e_win; const float* e_scw; const float* e_scb; const float* e_qg; const float* e_kvg; const float* e_wuq; const float* e_wukv; const float* e_wout;
    const float* o_win; const float* o_cw; const float* o_cb; const float* o_lng; const float* o_lnb; const float* o_wout;
    float* out; unsigned char* ws; int ph_lo, ph_hi;
};

__device__ __forceinline__ void tr_item(const float* __restrict__ W, int N, const float* __restrict__ gk, bf16* __restrict__ WT, int ldt, int dst_row0, float* scr, int k0, int n0, int lane) {
#pragma unroll 8
    for (int i = 0; i < 32; ++i) { const int kk = 2 * i + (lane >> 5); float v = W[(size_t)(k0 + kk) * N + n0 + (lane & 31)]; if (gk) v *= gk[k0 + kk]; scr[kk * 33 + (lane & 31)] = v; }
    asm volatile("s_waitcnt lgkmcnt(0)" ::: "memory");
    const int c = lane & 7;
#pragma unroll
    for (int j = 0; j < 4; ++j) { const int n = (lane >> 3) + 8 * j; const float* s = scr + (8 * c) * 33 + n;
        u32x4 o; o.x = cvtpk(s[0 * 33], s[1 * 33]); o.y = cvtpk(s[2 * 33], s[3 * 33]); o.z = cvtpk(s[4 * 33], s[5 * 33]); o.w = cvtpk(s[6 * 33], s[7 * 33]);
        *(u32x4*)(WT + (size_t)(dst_row0 + n) * ldt + k0 + 8 * c) = o; }
    asm volatile("s_waitcnt lgkmcnt(0)" ::: "memory");
}

__device__ __forceinline__ void p0_phase(const Args& a, char* lds, int G, int wave_s) {
    const int tid = opaque_tid(wave_s), lane = tid & 63, wave = wave_s;
    unsigned char* ws = a.ws;
    {
        float* cact = (float*)lds; float* part = (float*)(lds + 16384); float* mod = (float*)(ws + WS_MOD);
        for (int task = blockIdx.x; task < 192; task += G) {
            const int l = task / 48, n0 = (task % 48) * 64;
            for (int i = tid; i < 4096; i += 512) { const float v = a.c[i]; cact[i] = siluf_(v); }
            __syncthreads();
            const float* W = a.ada_w + (size_t)l * 1024 * 3072 + n0 + lane; const int k0 = wave * 128;
            float a0 = 0.f, a1 = 0.f, a2 = 0.f, a3 = 0.f;
#pragma unroll 8
            for (int k = 0; k < 128; ++k) { const float w = W[(size_t)(k0 + k) * 3072]; a0 += cact[k0 + k] * w; a1 += cact[1024 + k0 + k] * w; a2 += cact[2048 + k0 + k] * w; a3 += cact[3072 + k0 + k] * w; }
            part[(wave * 4 + 0) * 64 + lane] = a0; part[(wave * 4 + 1) * 64 + lane] = a1; part[(wave * 4 + 2) * 64 + lane] = a2; part[(wave * 4 + 3) * 64 + lane] = a3;
            __syncthreads();
            if (tid < 256) { const int b = tid >> 6, j = tid & 63; float s = 0.f;
#pragma unroll
                for (int w = 0; w < 8; ++w) s += part[(w * 4 + b) * 64 + j];
                mod[(size_t)(l * 4 + b) * 3072 + n0 + j] = s + a.ada_b[l * 3072 + n0 + j]; }
            __syncthreads();
        }
    }
    {
        float* scr = (float*)(lds + wave * 16384);
        const int gw = blockIdx.x * 8 + wave, NGW = G * 8;
        constexpr int I_EW = 16 * 93, I_UQ = 4 * 24, I_UKV = 2 * 32, I_WO = 16 * 32, I_OW = 16 * 96;
        constexpr int NITEMS = 2 * (I_EW + I_UQ + I_UKV + I_WO + I_OW + I_WO);
        for (int it = gw; it < NITEMS; it += NGW) {
            int r = it;
            if (r < 2 * I_EW) { const int li = r / I_EW, rr = r % I_EW, kb = rr / 93, nb = rr % 93;
                tr_item(a.e_win + (size_t)li * 1024 * EVEN_IN, EVEN_IN, nullptr, (bf16*)(ws + WS_EWIN) + (size_t)li * 3072 * 1024, 1024, 32 * nb, scr, 64 * kb, 32 * nb, lane); continue; } r -= 2 * I_EW;
            if (r < 2 * I_OW) { const int li = r / I_OW, rr = r % I_OW, kb = rr / 96, nb = rr % 96; const int n0 = 32 * nb;
                int drow; if (n0 < 2048) { const int part = n0 >> 10, ch = n0 & 1023; drow = 256 * (ch >> 7) + 128 * part + (ch & 127); } else drow = n0;
                tr_item(a.o_win + (size_t)li * 1024 * 3072, 3072, nullptr, (bf16*)(ws + WS_OWIN) + (size_t)li * 3072 * 1024, 1024, drow, scr, 64 * kb, n0, lane); continue; } r -= 2 * I_OW;
            if (r < 2 * I_WO) { const int li = r / I_WO, rr = r % I_WO, kb = rr / 32, nb = rr % 32;
                tr_item(a.e_wout + (size_t)li * 1024 * 1024, 1024, nullptr, (bf16*)(ws + WS_EWOUT) + (size_t)li * 1024 * 1024, 1024, 32 * nb, scr, 64 * kb, 32 * nb, lane); continue; } r -= 2 * I_WO;
            if (r < 2 * I_WO) { const int li = r / I_WO, rr = r % I_WO, kb = rr / 32, nb = rr % 32;
                tr_item(a.o_wout + (size_t)li * 1024 * 1024, 1024, nullptr, (bf16*)(ws + WS_OWOUT) + (size_t)li * 1024 * 1024, 1024, 32 * nb, scr, 64 * kb, 32 * nb, lane); continue; } r -= 2 * I_WO;
            if (r < 2 * I_UQ) { const int li = r / I_UQ, rr = r % I_UQ, kb = rr / 24, nb = rr % 24;
                tr_item(a.e_wuq + (size_t)li * 256 * 768, 768, a.e_qg + li * 256, (bf16*)(ws + WS_WUQ) + (size_t)li * 768 * 256, 256, 32 * nb, scr, 64 * kb, 32 * nb, lane); continue; } r -= 2 * I_UQ;
            { const int li = r / I_UKV, rr = r % I_UKV, kb = rr / 32, nb = rr % 32;
                tr_item(a.e_wukv + (size_t)li * 128 * 1024, 1024, a.e_kvg + li * 128, (bf16*)(ws + WS_WUKV) + (size_t)li * 1024 * 128, 128, 32 * nb, scr, 64 * kb, 32 * nb, lane); }
        }
    }
    {
        const int gt = blockIdx.x * 512 + tid, NGT = G * 512;
        for (int e = gt; e < 2 * 96 * 128; e += NGT) { const int li = e / (96 * 128), rr = e % (96 * 128);
            *(u32x4*)((bf16*)(ws + WS_EWIN) + (size_t)li * 3072 * 1024 + (size_t)EVEN_IN * 1024 + (size_t)rr * 8) = (u32x4){0u, 0u, 0u, 0u}; }
        float* cosT = (float*)(ws + WS_COS); float* sinT = (float*)(ws + WS_SIN);
        for (int e = gt; e < M * 16; e += NGT) { const int m = e >> 4, i = e & 15;
            const float inv_freq = 1.0f / powf(10000.0f, (float)(2 * i) * (1.0f / 32.0f));
            const float x = (float)a.pos[m] * inv_freq;
            const float n = rintf(x * 0.15915494309189535f);
            float r = fmaf(-n, 6.28125f, x); r = fmaf(-n, 1.9353071795864769e-3f, r);
            cosT[e] = cosf(r); sinT[e] = sinf(r); }
    }
}

template <bool HAS_POST, bool HAS_PRE>
__device__ __forceinline__ void norm_phase(const float* __restrict__ xin, float* __restrict__ xout, bf16* Hb, const float* mod_prev, const float* postg, const float* mod_next, const float* preg,
                                           int G, int wave_s) {
    const int tid = opaque_tid(wave_s), lane = tid & 63, wave = wave_s;
    const int gw = blockIdx.x * 8 + wave, NGW = G * 8;
    for (int ch = gw; ch < M / 8; ch += NGW) {
        const int row0 = ch * 8, b = row0 / SEQ;
        f32x4 GA[4], PB[4], SH[4];
#pragma unroll
        for (int j = 0; j < 4; ++j) { const int c = 4 * lane + 256 * j;
            if (HAS_POST) { GA[j] = *(const f32x4*)(mod_prev + (size_t)b * 3072 + 2048 + c) * *(const f32x4*)(postg + c); }
            if (HAS_PRE) { PB[j] = *(const f32x4*)(preg + c) * (*(const f32x4*)(mod_next + (size_t)b * 3072 + 1024 + c) + 1.0f); SH[j] = *(const f32x4*)(mod_next + (size_t)b * 3072 + c); } }
#pragma unroll 2
        for (int rr = 0; rr < 8; ++rr) { const size_t row = row0 + rr;
            f32x4 xv[4];
#pragma unroll
            for (int j = 0; j < 4; ++j) xv[j] = *(const f32x4*)(xin + row * DM + 4 * lane + 256 * j);
            if (HAS_POST) {
                f32x4 yv[4]; float s = 0.f;
#pragma unroll
                for (int j = 0; j < 4; ++j) { const u32x2 w = *(const u32x2*)(Hb + row * DM + 4 * lane + 256 * j); yv[j] = (f32x4){bflo(w.x), bfhi(w.x), bflo(w.y), bfhi(w.y)};
                    s += (yv[j][0] * yv[j][0] + yv[j][1] * yv[j][1]) + (yv[j][2] * yv[j][2] + yv[j][3] * yv[j][3]); }
                const float rstd = rsqrtf(wave_sum(s) * (1.f / DM) + EPS);
#pragma unroll
                for (int j = 0; j < 4; ++j) { xv[j] = xv[j] + GA[j] * (yv[j] * rstd); *(f32x4*)(xout + row * DM + 4 * lane + 256 * j) = xv[j]; }
            }
            if (HAS_PRE) {
                float s = 0.f;
#pragma unroll
                for (int j = 0; j < 4; ++j) s += (xv[j][0] * xv[j][0] + xv[j][1] * xv[j][1]) + (xv[j][2] * xv[j][2] + xv[j][3] * xv[j][3]);
                const float rstd = rsqrtf(wave_sum(s) * (1.f / DM) + EPS);
#pragma unroll
                for (int j = 0; j < 4; ++j) { const f32x4 hv = (xv[j] * rstd) * PB[j] + SH[j]; u32x2 w; w.x = cvtpk(hv[0], hv[1]); w.y = cvtpk(hv[2], hv[3]);
                    *(u32x2*)(Hb + row * DM + 4 * lane + 256 * j) = w; }
            }
        }
    }
}

__device__ __forceinline__ void ew_even_phase(const bf16* __restrict__ Z, bf16* __restrict__ CAT, bf16* __restrict__ KR, const float* __restrict__ scw, const float* __restrict__ scb,
                                              const float* __restrict__ cosT, const float* __restrict__ sinT, int G, int wave_s) {
    const int tid = opaque_tid(wave_s), lane = tid & 63, wave = wave_s;
    const int gw = blockIdx.x * 8 + wave, NGW = G * 8;
    const int c0 = 8 * lane;
    float w0[8], w1[8], w2[8], bb[8];
#pragma unroll
    for (int j = 0; j < 8; ++j) { w0[j] = scw[c0 + j]; w1[j] = scw[512 + c0 + j]; w2[j] = scw[1024 + c0 + j]; bb[j] = scb[c0 + j]; }
    for (int ch = gw; ch < M / 8; ch += NGW) {
        const int row0 = ch * 8, s0 = row0 % SEQ;
        float pm2[8], pm1[8];
        if (s0 == 0) {
#pragma unroll
            for (int j = 0; j < 8; ++j) { pm2[j] = 0.f; pm1[j] = 0.f; }
        } else {
            const u32x4 c2 = *(const u32x4*)(Z + (size_t)(row0 - 2) * ZLD + 512 + c0), x2 = *(const u32x4*)(Z + (size_t)(row0 - 2) * ZLD + 1024 + c0);
            const u32x4 c1 = *(const u32x4*)(Z + (size_t)(row0 - 1) * ZLD + 512 + c0), x1 = *(const u32x4*)(Z + (size_t)(row0 - 1) * ZLD + 1024 + c0);
#pragma unroll
            for (int q = 0; q < 4; ++q) { pm2[2 * q] = bflo(c2[q]) * bflo(x2[q]); pm2[2 * q + 1] = bfhi(c2[q]) * bfhi(x2[q]); pm1[2 * q] = bflo(c1[q]) * bflo(x1[q]); pm1[2 * q + 1] = bfhi(c1[q]) * bfhi(x1[q]); }
        }
#pragma unroll 2
        for (int rr = 0; rr < 8; ++rr) { const size_t row = row0 + rr; const bf16* zr = Z + row * ZLD;
            const u32x4 vb = *(const u32x4*)(zr + c0), vc = *(const u32x4*)(zr + 512 + c0), vx = *(const u32x4*)(zr + 1024 + c0), vg = *(const u32x4*)(zr + 1536 + c0);
            float p[8], ab[8], ag[8];
#pragma unroll
            for (int q = 0; q < 4; ++q) { p[2 * q] = bflo(vc[q]) * bflo(vx[q]); p[2 * q + 1] = bfhi(vc[q]) * bfhi(vx[q]); ab[2 * q] = bflo(vb[q]); ab[2 * q + 1] = bfhi(vb[q]); ag[2 * q] = bflo(vg[q]); ag[2 * q + 1] = bfhi(vg[q]); }
            float o[8];
#pragma unroll
            for (int j = 0; j < 8; ++j) { const float cv = w0[j] * pm2[j] + w1[j] * pm1[j] + w2[j] * p[j] + bb[j]; o[j] = ab[j] * cv * siluf_(ag[j]); pm2[j] = pm1[j]; pm1[j] = p[j]; }
            u32x4 w; w.x = cvtpk(o[0], o[1]); w.y = cvtpk(o[2], o[3]); w.z = cvtpk(o[4], o[5]); w.w = cvtpk(o[6], o[7]);
            *(u32x4*)(CAT + row * 1024 + c0) = w;
            if (lane < 16) { const float t1 = bflo((unsigned)zr[COL_KR + lane]), t2 = bflo((unsigned)zr[COL_KR + 16 + lane]); const float cs = cosT[row * 16 + lane], sn = sinT[row * 16 + lane];
                const float o1 = t1 * cs - t2 * sn, o2 = t2 * cs + t1 * sn;
                KR[row * 32 + lane] = (bf16)(cvtpk(o1, o1) & 0xffffu); KR[row * 32 + 16 + lane] = (bf16)(cvtpk(o2, o2) & 0xffffu); }
        }
    }
}

__device__ __forceinline__ void conv_odd_phase(const bf16* __restrict__ U, const bf16* __restrict__ SG, bf16* __restrict__ A2, const float* __restrict__ cw, const float* __restrict__ cb,
                                               const float* __restrict__ lng, const float* __restrict__ lnb, char* lds, int G, int wave_s) {
    const int tid = opaque_tid(wave_s), lane = tid & 63, wave = wave_s;
    typedef float f32x2 __attribute__((ext_vector_type(2)));
    float* cbuf = (float*)lds;
    f32x2 w[31];
#pragma unroll
    for (int k = 0; k < 31; ++k) w[k] = *(const f32x2*)(cw + k * 1024 + 2 * tid);
    const f32x2 bias = *(const f32x2*)(cb + 2 * tid);
    f32x4 lg[4], lb[4];
#pragma unroll
    for (int j = 0; j < 4; ++j) { lg[j] = *(const f32x4*)(lng + 4 * lane + 256 * j); lb[j] = *(const f32x4*)(lnb + 4 * lane + 256 * j); }
    for (int tile = blockIdx.x; tile < M / 16; tile += G) {
        const int t0 = tile * 16, s0 = t0 % SEQ;
        f32x2 acc[16];
#pragma unroll
        for (int j = 0; j < 16; ++j) acc[j] = bias;
#pragma unroll
        for (int i = 0; i < 46; ++i) {
            f32x2 v = (f32x2){0.f, 0.f};
            if (s0 - 30 + i >= 0) { const unsigned uw = *(const unsigned*)(U + (size_t)(t0 - 30 + i) * 1024 + 2 * tid); v = (f32x2){bflo(uw), bfhi(uw)}; }
#pragma unroll
            for (int j = 0; j < 16; ++j) { const int k = i - j; if (k >= 0 && k <= 30) acc[j] += w[k] * v; }
        }
#pragma unroll
        for (int j = 0; j < 16; ++j) *(f32x2*)(cbuf + j * 1024 + 2 * tid) = acc[j];
        __syncthreads();
#pragma unroll
        for (int jj = 0; jj < 2; ++jj) { const int j = 2 * wave + jj; const size_t row = t0 + j;
            f32x4 v[4]; float s = 0.f;
#pragma unroll
            for (int q = 0; q < 4; ++q) { v[q] = *(const f32x4*)(cbuf + j * 1024 + 4 * lane + 256 * q); s += (v[q][0] + v[q][1]) + (v[q][2] + v[q][3]); }
            const float mean = wave_sum(s) * (1.f / 1024.f); float s2 = 0.f;
#pragma unroll
            for (int q = 0; q < 4; ++q) { v[q] = v[q] - mean; s2 += (v[q][0] * v[q][0] + v[q][1] * v[q][1]) + (v[q][2] * v[q][2] + v[q][3] * v[q][3]); }
            const float rstd = rsqrtf(wave_sum(s2) * (1.f / 1024.f) + EPS);
#pragma unroll
            for (int q = 0; q < 4; ++q) { const u32x2 gw_ = *(const u32x2*)(SG + row * 1024 + 4 * lane + 256 * q);
                f32x4 y = (v[q] * rstd) * lg[q] + lb[q];
                const f32x4 sg = (f32x4){bflo(gw_.x), bfhi(gw_.x), bflo(gw_.y), bfhi(gw_.y)};
#pragma unroll
                for (int e = 0; e < 4; ++e) y[e] = siluf_(y[e]) * sg[e];
                u32x2 ow; ow.x = cvtpk(y[0], y[1]); ow.y = cvtpk(y[2], y[3]);
                *(u32x2*)(A2 + row * 1024 + 4 * lane + 256 * q) = ow; }
        }
        __syncthreads();
    }
}

__global__ void __launch_bounds__(512, 2) mk_fwd(Args a) {
    extern __shared__ __attribute__((aligned(16))) unsigned char lds[];
    cg::grid_group grid = cg::this_grid();
    const int G = gridDim.x;
    const int wave_s = __builtin_amdgcn_readfirstlane((int)threadIdx.x >> 6);
    const int vcu = (G % 8 == 0) ? ((int)blockIdx.x % 8) * (G / 8) + (int)blockIdx.x / 8 : (int)blockIdx.x;
    unsigned char* ws = a.ws;
    float* mod = (float*)(ws + WS_MOD); float* ssq_q = (float*)(ws + WS_SSQ_Q); float* ssq_kv = (float*)(ws + WS_SSQ_KV);
    float* cosT = (float*)(ws + WS_COS); float* sinT = (float*)(ws + WS_SIN);
    bf16* KR = (bf16*)(ws + WS_KR); bf16* Hb = (bf16*)(ws + WS_H); bf16* Zb = (bf16*)(ws + WS_Z); bf16* KVb = (bf16*)(ws + WS_KV); bf16* CAT = (bf16*)(ws + WS_CAT);
    PG8_LAS unsigned char* ldsL = (PG8_LAS unsigned char*)lds;
    volatile LAS unsigned* bst = (volatile LAS unsigned*)(ldsL + 131072 + 64);
    if (threadIdx.x < 2) bst[threadIdx.x] = 0u;
    __syncthreads();
    XcdBarrier xbar = xcd_barrier_post((unsigned*)ws, bst);
    int ph = 0; const int lo = a.ph_lo, hi = a.ph_hi;
#define PH_BEGIN(REP) if (ph >= lo && ph < hi) { _Pragma("unroll") for (int rep_ = 0; rep_ < (REP); ++rep_) {
#define PH_END } } ++ph; if (ph > lo && ph < hi) { _Pragma("unroll") for (int rs_ = 0; rs_ < REP_SYNC; ++rs_) { if (ph == 1) grid.sync(); else xcd_barrier(xbar); } }

    PH_BEGIN(REP_P0) p0_phase(a, (char*)lds, G, wave_s); PH_END
    PH_BEGIN(REP_NORM0) norm_phase<false, true>(a.x, nullptr, Hb, nullptr, nullptr, mod, a.pre_g, G, wave_s); PH_END

#define LAYER_BODY(layer) do { \
        const int li = layer >> 1; \
        if ((layer & 1) == 0) { \
            PH_BEGIN(REP_GIN) \
                pg8::Gemm g{Hb, 1024, (const bf16*)(ws + WS_EWIN) + (size_t)li * 3072 * 1024, 1024, M, 3072, 1024, wave_s}; pg8::StaticOrder S; S.init(M, 3072, G, (int)blockIdx.x); \
                EpiEvenIn E{Zb, ssq_q, ssq_kv}; \
                pg8::gemm_phase<EpiEvenIn, pg8::StaticOrder, true, true>(ldsL, g, S, E); \
            PH_END \
            PH_BEGIN(REP_E2) \
                { pg8::Gemm g{Zb + COL_CQ, ZLD, (const bf16*)(ws + WS_WUQ) + (size_t)li * 768 * 256, 256, M, 768, 256, wave_s}; pg8::StaticOrder S; S.init(M, 768, G, (int)blockIdx.x); \
                  EpiQ E{Hb, ssq_q}; \
                  pg8::gemm_phase<EpiQ, pg8::StaticOrder, true, true>(ldsL, g, S, E); } \
                { pg8::Gemm g{Zb + COL_CKV, ZLD, (const bf16*)(ws + WS_WUKV) + (size_t)li * 1024 * 128, 128, M, 1024, 128, wave_s}; pg8::StaticOrder S; S.init(M, 1024, G, (int)blockIdx.x); \
                  EpiKV E{KVb, ssq_kv}; \
                  pg8::gemm_phase<EpiKV, pg8::StaticOrder, true, true>(ldsL, g, S, E); } \
                ew_even_phase(Zb, CAT, KR, a.e_scw + li * 3 * 512, a.e_scb + li * 512, cosT, sinT, G, wave_s); \
            PH_END \
            PH_BEGIN(REP_ATT) \
                for (int pi = vcu; pi < 256; pi += G) { const int bh = pi >> 3, s = pi & 7; \
                    att::attn_unit(bh >> 3, bh & 7, 15 - s, Hb, KVb, KR, Zb, CAT, cosT, sinT, (char*)lds, wave_s); \
                    att::attn_unit(bh >> 3, bh & 7, s, Hb, KVb, KR, Zb, CAT, cosT, sinT, (char*)lds, wave_s); } \
            PH_END \
            PH_BEGIN(REP_GOUT) \
                pg8::Gemm g{CAT, 1024, (const bf16*)(ws + WS_EWOUT) + (size_t)li * 1024 * 1024, 1024, M, 1024, 1024, wave_s}; pg8::StaticOrder S; S.init(M, 1024, G, (int)blockIdx.x); \
                EpiPlain E{Hb, 1024}; \
                pg8::gemm_phase<EpiPlain, pg8::StaticOrder, true, true>(ldsL, g, S, E); \
            PH_END \
        } else { \
            PH_BEGIN(REP_GIN) \
                pg8::Gemm g{Hb, 1024, (const bf16*)(ws + WS_OWIN) + (size_t)li * 3072 * 1024, 1024, M, 3072, 1024, wave_s}; pg8::StaticOrder S; S.init(M, 3072, G, (int)blockIdx.x); \
                EpiOddIn E{Zb, Zb + (size_t)M * 1024}; \
                pg8::gemm_phase<EpiOddIn, pg8::StaticOrder, true, true>(ldsL, g, S, E); \
            PH_END \
            PH_BEGIN(REP_CONV) \
                conv_odd_phase(Zb, Zb + (size_t)M * 1024, CAT, a.o_cw + li * 31 * 1024, a.o_cb + li * 1024, a.o_lng + li * 1024, a.o_lnb + li * 1024, (char*)lds, G, wave_s); \
            PH_END \
            PH_BEGIN(REP_GOUT) \
                pg8::Gemm g{CAT, 1024, (const bf16*)(ws + WS_OWOUT) + (size_t)li * 1024 * 1024, 1024, M, 1024, 1024, wave_s}; pg8::StaticOrder S; S.init(M, 1024, G, (int)blockIdx.x); \
                EpiPlain E{Hb, 1024}; \
                pg8::gemm_phase<EpiPlain, pg8::StaticOrder, true, true>(ldsL, g, S, E); \
            PH_END \
        } \
        PH_BEGIN(1) \
            const float* xin = (layer == 0) ? a.x : a.out; \
            if (layer < 3) norm_phase<true, true>(xin, a.out, Hb, mod + (size_t)layer * 4 * 3072, a.post_g + layer * 1024, mod + (size_t)(layer + 1) * 4 * 3072, a.pre_g + (layer + 1) * 1024, G, wave_s); \
            else norm_phase<true, false>(xin, a.out, Hb, mod + (size_t)layer * 4 * 3072, a.post_g + layer * 1024, nullptr, nullptr, G, wave_s); \
        PH_END \
    } while (0)
    LAYER_BODY(0); LAYER_BODY(1); LAYER_BODY(2); LAYER_BODY(3);
#undef LAYER_BODY
#undef PH_BEGIN
#undef PH_END
}

constexpr int N_PHASES = 2 + 5 + 4 + 5 + 4;

extern "C" void kernel_launch(void* const* d_in, const int* in_sizes, int n_in, void* d_out, int out_size, void* d_ws, size_t ws_size, hipStream_t stream) {
    static int grid = 0;
    if (grid == 0) {
        if (n_in != 21 || in_sizes[0] != M * DM || out_size != M * DM || ws_size < WS_END) { fprintf(stderr, "kernel_launch: unexpected shapes (n_in %d, ws %zu)\n", n_in, ws_size); grid = -1; return; }
        int dev = 0, cus = 0, per_cu = 0;
        hipGetDevice(&dev); hipDeviceGetAttribute(&cus, hipDeviceAttributeMultiprocessorCount, dev);
        if (hipFuncSetAttribute((const void*)mk_fwd, hipFuncAttributeMaxDynamicSharedMemorySize, LDS_BYTES) != hipSuccess) { fprintf(stderr, "kernel_launch: hipFuncSetAttribute failed\n"); grid = -1; return; }
        if (hipOccupancyMaxActiveBlocksPerMultiprocessor(&per_cu, (const void*)mk_fwd, 512, LDS_BYTES) != hipSuccess || per_cu < 1) { fprintf(stderr, "kernel_launch: occupancy query says %d\n", per_cu); per_cu = 1; }
        (void)hipGetLastError();
        grid = cus;
        fprintf(stderr, "kernel_launch: cus %d per_cu %d grid %d\n", cus, per_cu, grid);
    }
    if (grid < 0) return;
    Args a{};
    a.x = (const float*)d_in[0]; a.c = (const float*)d_in[1]; a.pos = (const int*)d_in[2]; a.ada_w = (const float*)d_in[3]; a.ada_b = (const float*)d_in[4];
    a.pre_g = (const float*)d_in[5]; a.post_g = (const float*)d_in[6]; a.e_win = (const float*)d_in[7]; a.e_scw = (const float*)d_in[8]; a.e_scb = (const float*)d_in[9];
    a.e_qg = (const float*)d_in[10]; a.e_kvg = (const float*)d_in[11]; a.e_wuq = (const float*)d_in[12]; a.e_wukv = (const float*)d_in[13]; a.e_wout = (const float*)d_in[14];
    a.o_win = (const float*)d_in[15]; a.o_cw = (const float*)d_in[16]; a.o_cb = (const float*)d_in[17]; a.o_lng = (const float*)d_in[18]; a.o_lnb = (const float*)d_in[19]; a.o_wout = (const float*)d_in[20];
    a.out = (float*)d_out; a.ws = (unsigned char*)d_ws;
#if MK_ONE_LAUNCH
    if (hipMemsetAsync(d_ws, 0, 16384, stream) != hipSuccess) { fprintf(stderr, "kernel_launch: memset failed\n"); return; }
    a.ph_lo = 0; a.ph_hi = N_PHASES;
    void* args[] = {&a};
    hipError_t e = hipLaunchCooperativeKernel((const void*)mk_fwd, dim3(grid), dim3(512), args, LDS_BYTES, stream);
    if (e != hipSuccess) fprintf(stderr, "kernel_launch: cooperative launch failed: %s (grid %d)\n", hipGetErrorString(e), grid);
#else
    for (int p = 0; p < N_PHASES; ++p) { a.ph_lo = p; a.ph_hi = p + 1; hipLaunchKernelGGL(mk_fwd, dim3(grid), dim3(512), LDS_BYTES, stream, a); }
#endif
}
```

```cpp
#include <hip/hip_runtime.h>
#include <hip/hip_cooperative_groups.h>
#include <cstdio>
#include <cstdint>
namespace cg = cooperative_groups;

#ifndef MK_ONE_LAUNCH
#define MK_ONE_LAUNCH 1
#endif
#ifndef REP_P0
#define REP_P0 1
#endif
#ifndef REP_NORM0
#define REP_NORM0 1
#endif
#ifndef REP_GIN
#define REP_GIN 1
#endif
#ifndef REP_E2
#define REP_E2 1
#endif
#ifndef REP_ATT
#define REP_ATT 1
#endif
#ifndef REP_GOUT
#define REP_GOUT 1
#endif
#ifndef REP_CONV
#define REP_CONV 1
#endif
#ifndef REP_SYNC
#define REP_SYNC 1
#endif

namespace pg8 {
#define PG8_LAS __attribute__((address_space(3)))
typedef unsigned short bf16_t;
typedef short bf16x8 __attribute__((ext_vector_type(8)));
typedef float f32x4 __attribute__((ext_vector_type(4)));
typedef unsigned u32x4 __attribute__((ext_vector_type(4)));
constexpr int BM = 256, BK = 64, HALF = 128, HTB = HALF * BK * 2, STAGE_BYTES = 8 * HTB, NXCD = 8, WGM = 8;

__host__ __device__ __forceinline__ int lds_byte(int r, int c) { const int st = (r >> 4) * 2 + (c >> 5), rr = r & 15, cc = c & 31, ob = rr * 64 + cc * 2; return st * 1024 + (ob ^ (((ob >> 9) & 1) << 5)); }
__host__ __device__ __forceinline__ void stage_rc(int b, int& R, int& C) { const int st = b / 1024, sb = b % 1024, swz = sb ^ (((sb >> 9) & 1) << 5); R = (st >> 1) * 16 + swz / 64; C = (st & 1) * 32 + (swz % 64) / 2; }
__host__ __device__ __forceinline__ int perm32(int rho) { const int n = rho >> 4, i = rho & 15; return 8 * (i >> 2) + 4 * n + (i & 3); }

struct Unit { int pm, pn; };
struct Gemm { const bf16_t* A; int lda; const bf16_t* Bt; int ldb; int M, N, K; int wave; };

struct StaticOrder {
    int nM, nN, nwg, G, c;
    __host__ __device__ void init(int M, int N, int G_, int c_) { nM = M / BM; nN = N / BM; nwg = nM * nN; G = G_; c = c_; }
    __host__ __device__ bool next(int i, Unit& u) const {
        const long L = (long)i * G + c; if (L >= nwg) return false;
        int wgid = (int)L; { const int q = nwg / NXCD, r = nwg % NXCD, xcd = wgid % NXCD, off = wgid / NXCD; wgid = (xcd < r ? xcd * (q + 1) : r * (q + 1) + (xcd - r) * q) + off; }
        const int nig = WGM * nN, gid = wgid / nig, fm = gid * WGM, gsz = (nM - fm) < WGM ? (nM - fm) : WGM;
        u.pm = fm + ((wgid % nig) % gsz); u.pn = (wgid % nig) / gsz; return true;
    }
    __device__ __forceinline__ void a_ready(const Unit&) const {}
    __device__ __forceinline__ void done(const Unit&) const {}
};

__device__ __forceinline__ unsigned cvt_pk_bf16(float lo, float hi) { unsigned r; asm volatile("v_cvt_pk_bf16_f32 %0, %1, %2" : "=v"(r) : "v"(lo), "v"(hi)); return r;}

template <class Epi, class Sched, bool ALIGN_EPI = false, bool SP2 = false>
__device__ __forceinline__ void gemm_phase(PG8_LAS unsigned char* lds, const Gemm g, const Sched& S, const Epi& E) {
    int lane; asm volatile("v_mbcnt_lo_u32_b32 %0, -1, 0\n\tv_mbcnt_hi_u32_b32 %0, -1, %0" : "=v"(lane)); int wid = g.wave; asm volatile("" : "+s"(wid)); const int tid = wid * 64 + lane, wr = wid >> 2, wc = wid & 3, fr = lane & 15, fq = lane >> 4;
    const int K = g.K, nt = K / BK;
    unsigned voffA[2], voffB[2];
#pragma unroll
    for (int i = 0; i < 2; ++i) { int R, C; stage_rc(tid * 16 + i * 8192, R, C); const int Rb = Epi::PERM ? ((R & ~31) + perm32(R & 31)) : R;
        voffA[i] = (unsigned)(R * g.lda + C) * 2u; voffB[i] = (unsigned)(Rb * g.ldb + C) * 2u; }
    const size_t kstep = (size_t)(BK * 2);
    const size_t hstepA = (size_t)HALF * g.lda * 2, hstepB = (size_t)HALF * g.ldb * 2;
    const size_t tstepA = 2 * hstepA, tstepB = 2 * hstepB;
    const unsigned ldsw = (unsigned)wid * 1024u;
    const int aoff = lds_byte(wr * 64 + fr, fq * 8), boff = lds_byte(wc * 32 + fr, fq * 8);
#define PG8_SA(b, h) (((b) * 2 + (h)) * HTB)
#define PG8_SB(b, h) ((4 + (b) * 2 + (h)) * HTB)
#define PG8_STAGE(bufoff, gbase, voff) do { _Pragma("unroll") for (int _i = 0; _i < 2; ++_i) \
        __builtin_amdgcn_global_load_lds((const unsigned*)((const char*)(gbase) + (voff)[_i]), (PG8_LAS unsigned*)(lds + (bufoff) + ldsw + _i * 8192), 16, 0, 0); } while (0)
#define PG8_LDA(dst, b, h) do { _Pragma("unroll") for (int m = 0; m < 4; ++m) _Pragma("unroll") for (int k = 0; k < 2; ++k) dst[m][k] = *(const PG8_LAS bf16x8*)(lds + PG8_SA(b, h) + aoff + m * 2048 + k * 1024); } while (0)
#define PG8_LDB(dst, b, h) do { _Pragma("unroll") for (int n = 0; n < 2; ++n) _Pragma("unroll") for (int k = 0; k < 2; ++k) dst[n][k] = *(const PG8_LAS bf16x8*)(lds + PG8_SB(b, h) + boff + n * 2048 + k * 1024); } while (0)
#define PG8_MMA(ai, bj, At, Bt) do { __builtin_amdgcn_s_setprio(1); _Pragma("unroll") for (int m = 0; m < 4; ++m) _Pragma("unroll") for (int n = 0; n < 2; ++n) _Pragma("unroll") for (int k = 0; k < 2; ++k) \
        acc[ai][bj][m][n] = __builtin_amdgcn_mfma_f32_16x16x32_bf16(Bt[n][k], At[m][k], acc[ai][bj][m][n], 0, 0, 0); __builtin_amdgcn_s_setprio(0); } while (0)
#define PG8_WAIT_V(n) asm volatile("s_waitcnt vmcnt(" #n ")" ::: "memory")
#define PG8_WAIT_L(n) asm volatile("s_waitcnt lgkmcnt(" #n ")" ::: "memory")
#define PG8_BAR __builtin_amdgcn_s_barrier()
#define PG8_SCHED __builtin_amdgcn_sched_barrier(0)
    Unit cur, nxt; int ui = 0;
    if (!S.next(0, cur)) return;
    f32x4 acc[2][2][4][2];
#pragma unroll
    for (int a = 0; a < 2; ++a)
#pragma unroll
        for (int b = 0; b < 2; ++b)
#pragma unroll
            for (int m = 0; m < 4; ++m)
#pragma unroll
                for (int n = 0; n < 2; ++n) acc[a][b][m][n] = (f32x4){0.f, 0.f, 0.f, 0.f};
    bf16x8 At[4][2], B0[2][2], B1[2][2];
    const char* cA = (const char*)g.A + (size_t)cur.pm * tstepA; const char* cB = (const char*)g.Bt + (size_t)cur.pn * tstepB;
    S.a_ready(cur);
    if constexpr (SP2) {
        PG8_STAGE(PG8_SB(0, 0), cB, voffB); PG8_STAGE(PG8_SB(0, 1), cB + hstepB, voffB); PG8_STAGE(PG8_SA(0, 0), cA, voffA); PG8_STAGE(PG8_SA(0, 1), cA + hstepA, voffA);
        if (wr == 1) PG8_BAR;
        PG8_WAIT_V(2); PG8_BAR;
        PG8_STAGE(PG8_SB(1, 0), cB + kstep, voffB); PG8_STAGE(PG8_SA(1, 0), cA + kstep, voffA); PG8_STAGE(PG8_SB(1, 1), cB + hstepB + kstep, voffB);
        PG8_WAIT_V(6); PG8_BAR;
    } else {
        PG8_STAGE(PG8_SB(0, 0), cB, voffB); PG8_STAGE(PG8_SA(0, 0), cA, voffA); PG8_STAGE(PG8_SB(0, 1), cB + hstepB, voffB); PG8_STAGE(PG8_SA(0, 1), cA + hstepA, voffA);
        if (wr == 1) PG8_BAR;
        PG8_WAIT_V(4); PG8_BAR;
        PG8_STAGE(PG8_SB(1, 0), cB + kstep, voffB); PG8_STAGE(PG8_SA(1, 0), cA + kstep, voffA); PG8_STAGE(PG8_SB(1, 1), cB + hstepB + kstep, voffB);
        PG8_WAIT_V(6); PG8_BAR;
    }
    for (;;) {
        const bool has_next = S.next(ui + 1, nxt);
        const char* nA = has_next ? (const char*)g.A + (size_t)nxt.pm * tstepA : cA; const char* nB = has_next ? (const char*)g.Bt + (size_t)nxt.pn * tstepB : cB;
        for (int t = 0; t < nt; t += 2) {
            const bool last = (t == nt - 2);
            const char* a1 = cA + (size_t)(t + 1) * kstep;
            const char* a2 = last ? nA : cA + (size_t)(t + 2) * kstep; const char* b2 = last ? nB : cB + (size_t)(t + 2) * kstep;
            const char* a3 = a2 + kstep; const char* b3 = b2 + kstep;
            if (last && has_next) S.a_ready(nxt);
            if constexpr (SP2) {
            PG8_LDB(B0, 0, 0); PG8_LDB(B1, 0, 1); PG8_SCHED; PG8_LDA(At, 0, 0); PG8_STAGE(PG8_SA(1, 1), a1 + hstepA, voffA);
            PG8_WAIT_V(8); PG8_WAIT_L(0); PG8_BAR; PG8_MMA(0, 0, At, B0); PG8_MMA(0, 1, At, B1); PG8_BAR; PG8_SCHED;
            PG8_LDA(At, 0, 1); PG8_STAGE(PG8_SB(0, 0), b2, voffB); PG8_STAGE(PG8_SB(0, 1), b2 + hstepB, voffB); PG8_STAGE(PG8_SA(0, 0), a2, voffA);
            PG8_WAIT_V(8); PG8_WAIT_L(0); PG8_BAR; PG8_MMA(1, 0, At, B0); PG8_MMA(1, 1, At, B1); PG8_BAR; PG8_SCHED;
            PG8_LDB(B0, 1, 0); PG8_LDB(B1, 1, 1); PG8_SCHED; PG8_LDA(At, 1, 0); PG8_STAGE(PG8_SA(0, 1), a2 + hstepA, voffA);
            PG8_WAIT_V(8); PG8_WAIT_L(0); PG8_BAR; PG8_MMA(0, 0, At, B0); PG8_MMA(0, 1, At, B1); PG8_BAR; PG8_SCHED;
            PG8_LDA(At, 1, 1); PG8_STAGE(PG8_SB(1, 0), b3, voffB); PG8_STAGE(PG8_SB(1, 1), b3 + hstepB, voffB); PG8_STAGE(PG8_SA(1, 0), a3, voffA);
            PG8_WAIT_V(8); PG8_WAIT_L(0); PG8_BAR; PG8_MMA(1, 0, At, B0); PG8_MMA(1, 1, At, B1); PG8_BAR; PG8_SCHED;
            } else {
            PG8_LDB(B0, 0, 0); PG8_SCHED; PG8_LDA(At, 0, 0); PG8_STAGE(PG8_SA(1, 1), a1 + hstepA, voffA);
            PG8_WAIT_L(8); PG8_BAR; PG8_WAIT_L(0); PG8_MMA(0, 0, At, B0); PG8_BAR; PG8_SCHED;
            PG8_LDB(B1, 0, 1); PG8_STAGE(PG8_SB(0, 0), b2, voffB);
            PG8_BAR; PG8_WAIT_L(0); PG8_MMA(0, 1, At, B1); PG8_BAR;
            PG8_LDA(At, 0, 1); PG8_STAGE(PG8_SA(0, 0), a2, voffA);
            PG8_BAR; PG8_WAIT_L(0); PG8_MMA(1, 0, At, B0); PG8_BAR; PG8_SCHED;
            PG8_STAGE(PG8_SB(0, 1), b2 + hstepB, voffB);
            PG8_WAIT_V(6); PG8_BAR; PG8_MMA(1, 1, At, B1); PG8_BAR;
            PG8_LDB(B0, 1, 0); PG8_SCHED; PG8_LDA(At, 1, 0); PG8_STAGE(PG8_SA(0, 1), a2 + hstepA, voffA);
            PG8_WAIT_L(8); PG8_BAR; PG8_WAIT_L(0); PG8_MMA(0, 0, At, B0); PG8_BAR; PG8_SCHED;
            PG8_LDB(B1, 1, 1); PG8_STAGE(PG8_SB(1, 0), b3, voffB);
            PG8_BAR; PG8_WAIT_L(0); PG8_MMA(0, 1, At, B1); PG8_BAR;
            PG8_LDA(At, 1, 1); PG8_STAGE(PG8_SA(1, 0), a3, voffA);
            PG8_BAR; PG8_WAIT_L(0); PG8_MMA(1, 0, At, B0); PG8_BAR; PG8_SCHED;
            PG8_STAGE(PG8_SB(1, 1), b3 + hstepB, voffB);
            PG8_WAIT_V(6); PG8_BAR; PG8_MMA(1, 1, At, B1); PG8_BAR;
            }
        }
        if constexpr (ALIGN_EPI) { if (wr == 0) PG8_BAR; }
        E(acc, cur, wr, wc, fr, fq); S.done(cur);
        if (!has_next) break;
#pragma unroll
        for (int a = 0; a < 2; ++a)
#pragma unroll
            for (int b = 0; b < 2; ++b)
#pragma unroll
                for (int m = 0; m < 4; ++m)
#pragma unroll
                    for (int n = 0; n < 2; ++n) acc[a][b][m][n] = (f32x4){0.f, 0.f, 0.f, 0.f};
        cur = nxt; cA = nA; cB = nB; ++ui;
        if constexpr (ALIGN_EPI) { if (wr == 1) PG8_BAR; }
    }
    PG8_WAIT_V(0);
    if constexpr (!ALIGN_EPI) { if (wr == 0) PG8_BAR; }
    PG8_BAR;
#undef PG8_SA
#undef PG8_SB
#undef PG8_STAGE
#undef PG8_LDA
#undef PG8_LDB
#undef PG8_MMA
#undef PG8_WAIT_V
#undef PG8_WAIT_L
#undef PG8_BAR
#undef PG8_SCHED
}
}

typedef unsigned short bf16;
typedef short bf16x8 __attribute__((ext_vector_type(8)));
typedef short s16x4 __attribute__((ext_vector_type(4)));
typedef float f32x4 __attribute__((ext_vector_type(4)));
typedef float f32x16 __attribute__((ext_vector_type(16)));
typedef unsigned u32x4 __attribute__((ext_vector_type(4)));
typedef unsigned u32x2 __attribute__((ext_vector_type(2)));
#define LAS __attribute__((address_space(3)))

constexpr int M = 16384, DM = 1024, SEQ = 4096, NBATCH = 4;
constexpr int EVEN_IN = 2976, ZLD = 3072;
constexpr int COL_CQ = 2048, COL_CKV = 2304, COL_KR = 2432, COL_BG = 2464;
constexpr float EPS = 1e-6f;
constexpr size_t MiB = 1u << 20;
constexpr size_t WS_MOD = 1 * MiB;
constexpr size_t WS_SSQ_Q = 1 * MiB + 256 * 1024;
constexpr size_t WS_SSQ_KV = 1 * MiB + 512 * 1024;
constexpr size_t WS_COS = 2 * MiB, WS_SIN = 3 * MiB;
constexpr size_t WS_KR = 4 * MiB;
constexpr size_t WS_EWIN = 6 * MiB;
constexpr size_t WS_OWIN = 18 * MiB;
constexpr size_t WS_EWOUT = 30 * MiB;
constexpr size_t WS_OWOUT = 34 * MiB;
constexpr size_t WS_WUQ = 38 * MiB;
constexpr size_t WS_WUKV = 39 * MiB;
constexpr size_t WS_H = 40 * MiB;
constexpr size_t WS_Z = 72 * MiB;
constexpr size_t WS_KV = 168 * MiB;
constexpr size_t WS_CAT = 200 * MiB;
constexpr size_t WS_END = 232 * MiB;
constexpr int LDS_BYTES = 147456;

__device__ __forceinline__ unsigned cvtpk(float lo, float hi) { unsigned r; asm volatile("v_cvt_pk_bf16_f32 %0, %1, %2" : "=v"(r) : "v"(lo), "v"(hi)); return r; }
__device__ __forceinline__ float bflo(unsigned w) { return __uint_as_float(w << 16); }
__device__ __forceinline__ float bfhi(unsigned w) { return __uint_as_float(w & 0xffff0000u); }
__device__ __forceinline__ float sigmoidf_(float x) { return 1.f / (1.f + __expf(-x)); }
__device__ __forceinline__ float siluf_(float x) { return x / (1.f + __expf(-x)); }
__device__ __forceinline__ int opaque_tid(int wave_s) { int l; asm volatile("v_mbcnt_lo_u32_b32 %0, -1, 0\n\tv_mbcnt_hi_u32_b32 %0, -1, %0" : "=v"(l)); asm volatile("" : "+s"(wave_s)); return wave_s * 64 + l; }
__device__ __forceinline__ float wave_sum(float v) {
#pragma unroll
    for (int o = 1; o < 64; o <<= 1) v += __shfl_xor(v, o);
    return v;
}


#define XB_TMO      128
#define XB_XCNT(j)  (256  + 64 * (j))
#define XB_XSUB(j)  (1280 + 64 * (j))
#define XB_XGEN(j)  (2304 + 64 * (j))
#define XB_TOP      3328
#define XB_TOPGEN   3392
#define XCD_BAR_WORDS 3456
#define XB_SPIN_CAP (1u << 18)
__device__ __forceinline__ unsigned xb_ld(unsigned* p)              { return __hip_atomic_load(p, __ATOMIC_RELAXED, __HIP_MEMORY_SCOPE_AGENT); }
__device__ __forceinline__ unsigned xb_add(unsigned* p, unsigned v) { return __hip_atomic_fetch_add(p, v, __ATOMIC_RELAXED, __HIP_MEMORY_SCOPE_AGENT); }
__device__ __forceinline__ unsigned xb_xcc_id() { return (unsigned)__builtin_amdgcn_s_getreg((3 << 11) | 20) & 0xFu; }
#define XB_SPIN(cond, bar) do { unsigned _sp = 0; while (cond) { __builtin_amdgcn_s_sleep(1); \
    if ((++_sp & 255u) == 0u) { if (xb_ld(&(bar)[XB_TMO])) break; if (_sp > XB_SPIN_CAP) { atomicAdd(&(bar)[XB_TMO], 1u); break; } } } } while (0)
struct XcdBarrier { unsigned* bar; unsigned x; volatile LAS unsigned* st; };
__device__ __forceinline__ XcdBarrier xcd_barrier_post(unsigned* bar, volatile LAS unsigned* st) {
    XcdBarrier b; b.bar = bar; b.x = xb_xcc_id(); b.st = st;
    if (threadIdx.x == 0) (void)xb_add(&bar[XB_XCNT(b.x)], 1u);
    return b;
}
__device__ __forceinline__ void xcd_barrier_complete(unsigned* bar, unsigned x, unsigned& nloc, unsigned& nx) {
    const unsigned G = gridDim.x * gridDim.y * gridDim.z;
    unsigned sum, cnt, mine, sp = 0u;
    for (;;) {
        sum = 0u; cnt = 0u; mine = 0u;
#pragma unroll
        for (unsigned j = 0; j < 16; ++j) { const unsigned c = xb_ld(&bar[XB_XCNT(j)]); sum += c; cnt += (c > 0u) ? 1u : 0u; mine = (j == x) ? c : mine; }
        if (sum == G) break;
        __builtin_amdgcn_s_sleep(1);
        if ((++sp & 255u) == 0u) { if (xb_ld(&bar[XB_TMO])) break; if (sp > XB_SPIN_CAP) { atomicAdd(&bar[XB_TMO], 1u); break; } }
    }
    nloc = mine > 0u ? mine : 1u; nx = cnt > 0u ? cnt : 1u;
}
__device__ __forceinline__ void xcd_barrier(const XcdBarrier& b) {
    asm volatile("s_waitcnt vmcnt(0)" ::: "memory");
    __syncthreads();
    if (threadIdx.x == 0) {
        unsigned* bar = b.bar;
        __builtin_amdgcn_s_waitcnt(0);
        unsigned nloc = b.st[0], nx = b.st[1];
        if (nloc == 0u) { xcd_barrier_complete(bar, b.x, nloc, nx); b.st[0] = nloc; b.st[1] = nx; }
        const unsigned old = xb_add(&bar[XB_XSUB(b.x)], 1u);
        const unsigned gen = old / nloc;
        if (old + 1u == (gen + 1u) * nloc) {
            __builtin_amdgcn_fence(__ATOMIC_RELEASE, "agent");
            asm volatile("s_waitcnt vmcnt(0)" ::: "memory");
            const unsigned og = xb_add(&bar[XB_TOP], 1u);
            const unsigned tg = og / nx;
            if (og + 1u == (tg + 1u) * nx) xb_add(&bar[XB_TOPGEN], 1u);
            else XB_SPIN(xb_ld(&bar[XB_TOPGEN]) == tg, bar);
            __builtin_amdgcn_fence(__ATOMIC_ACQUIRE, "agent");
            xb_add(&bar[XB_XGEN(b.x)], 1u);
            asm volatile("s_waitcnt vmcnt(0)" ::: "memory");
        } else {
            XB_SPIN(xb_ld(&bar[XB_XGEN(b.x)]) == gen, bar);
            __builtin_amdgcn_fence(__ATOMIC_ACQUIRE, "agent");
            asm volatile("s_waitcnt vmcnt(0)" ::: "memory");
        }
    }
    __syncthreads();
}

using pg8::Unit;
struct EpiEvenIn {
    static constexpr bool PERM = true, AFTER_DRAIN = false;
    bf16* Z; float* ssq_q; float* ssq_kv;
    __device__ __forceinline__ void operator()(const f32x4 (&acc)[2][2][4][2], const Unit& u, int wr, int wc, int fr, int fq) const {
        const int row0 = u.pm * 256 + wr * 64 + fr, col0 = u.pn * 256 + wc * 32 + 8 * fq;
#pragma unroll
        for (int ai = 0; ai < 2; ++ai)
#pragma unroll
            for (int m = 0; m < 4; ++m) { bf16* rowp = Z + (size_t)(row0 + ai * 128 + m * 16) * ZLD + col0;
#pragma unroll
                for (int bj = 0; bj < 2; ++bj) { const f32x4 v0 = acc[ai][bj][m][0], v1 = acc[ai][bj][m][1];
                    u32x4 w; w.x = cvtpk(v0[0], v0[1]); w.y = cvtpk(v0[2], v0[3]); w.z = cvtpk(v1[0], v1[1]); w.w = cvtpk(v1[2], v1[3]);
                    *(u32x4*)(rowp + bj * 128) = w; } }
        if (u.pn == 8 || u.pn == 9) {
            float* dst = (u.pn == 8) ? ssq_q : ssq_kv; const int nbj = (u.pn == 8) ? 2 : 1;
#pragma unroll
            for (int ai = 0; ai < 2; ++ai)
#pragma unroll
                for (int m = 0; m < 4; ++m) { float s = 0.f;
#pragma unroll
                    for (int bj = 0; bj < 2; ++bj) if (bj < nbj)
#pragma unroll
                        for (int n = 0; n < 2; ++n) { const f32x4 x = acc[ai][bj][m][n]; s += (x[0] * x[0] + x[1] * x[1]) + (x[2] * x[2] + x[3] * x[3]); }
                    s += __shfl_xor(s, 16); s += __shfl_xor(s, 32);
                    if (fq == 0) dst[(size_t)(row0 + ai * 128 + m * 16) * 4 + wc] = s; }
        }
    }
};
struct EpiQ {
    static constexpr bool PERM = true, AFTER_DRAIN = false;
    bf16* Q; const float* ssq_q;
    __device__ __forceinline__ void operator()(const f32x4 (&acc)[2][2][4][2], const Unit& u, int wr, int wc, int fr, int fq) const {
        const int row0 = u.pm * 256 + wr * 64 + fr, col0 = u.pn * 256 + wc * 32 + 8 * fq;
#pragma unroll
        for (int ai = 0; ai < 2; ++ai)
#pragma unroll
            for (int m = 0; m < 4; ++m) { const int row = row0 + ai * 128 + m * 16;
                const f32x4 pq = *(const f32x4*)(ssq_q + (size_t)row * 4);
                const float rstd = rsqrtf(((pq[0] + pq[1]) + (pq[2] + pq[3])) * (1.f / 256.f) + EPS);
#pragma unroll
                for (int bj = 0; bj < 2; ++bj) {
                    f32x4 v0 = acc[ai][bj][m][0] * rstd, v1 = acc[ai][bj][m][1] * rstd;
                    u32x4 w; w.x = cvtpk(v0[0], v0[1]); w.y = cvtpk(v0[2], v0[3]); w.z = cvtpk(v1[0], v1[1]); w.w = cvtpk(v1[2], v1[3]);
                    *(u32x4*)(Q + (size_t)row * 768 + col0 + bj * 128) = w; } }
    }
};
struct EpiKV {
    static constexpr bool PERM = true, AFTER_DRAIN = false;
    bf16* KV; const float* ssq_kv;
    __device__ __forceinline__ void operator()(const f32x4 (&acc)[2][2][4][2], const Unit& u, int wr, int wc, int fr, int fq) const {
        const int row0 = u.pm * 256 + wr * 64 + fr, col0 = u.pn * 256 + wc * 32 + 8 * fq;
#pragma unroll
        for (int ai = 0; ai < 2; ++ai)
#pragma unroll
            for (int m = 0; m < 4; ++m) { const int row = row0 + ai * 128 + m * 16;
                const f32x4 pq = *(const f32x4*)(ssq_kv + (size_t)row * 4);
                const float rstd = rsqrtf(((pq[0] + pq[1]) + (pq[2] + pq[3])) * (1.f / 128.f) + EPS);
#pragma unroll
                for (int bj = 0; bj < 2; ++bj) { const f32x4 v0 = acc[ai][bj][m][0] * rstd, v1 = acc[ai][bj][m][1] * rstd;
                    u32x4 w; w.x = cvtpk(v0[0], v0[1]); w.y = cvtpk(v0[2], v0[3]); w.z = cvtpk(v1[0], v1[1]); w.w = cvtpk(v1[2], v1[3]);
                    *(u32x4*)(KV + (size_t)row * 1024 + col0 + bj * 128) = w; } }
    }
};
struct EpiPlain {
    static constexpr bool PERM = true, AFTER_DRAIN = false;
    bf16* O; int ldc;
    __device__ __forceinline__ void operator()(const f32x4 (&acc)[2][2][4][2], const Unit& u, int wr, int wc, int fr, int fq) const {
        const int row0 = u.pm * 256 + wr * 64 + fr, col0 = u.pn * 256 + wc * 32 + 8 * fq;
#pragma unroll
        for (int ai = 0; ai < 2; ++ai)
#pragma unroll
            for (int m = 0; m < 4; ++m) { bf16* rowp = O + (size_t)(row0 + ai * 128 + m * 16) * ldc + col0;
#pragma unroll
                for (int bj = 0; bj < 2; ++bj) { const f32x4 v0 = acc[ai][bj][m][0], v1 = acc[ai][bj][m][1];
                    u32x4 w; w.x = cvtpk(v0[0], v0[1]); w.y = cvtpk(v0[2], v0[3]); w.z = cvtpk(v1[0], v1[1]); w.w = cvtpk(v1[2], v1[3]);
                    *(u32x4*)(rowp + bj * 128) = w; } }
    }
};
struct EpiOddIn {
    static constexpr bool PERM = true, AFTER_DRAIN = false;
    bf16* U; bf16* SG;
    __device__ __forceinline__ void operator()(const f32x4 (&acc)[2][2][4][2], const Unit& u, int wr, int wc, int fr, int fq) const {
        const int row0 = u.pm * 256 + wr * 64 + fr;
        if (u.pn < 8) {
            const int col0 = u.pn * 128 + wc * 32 + 8 * fq;
#pragma unroll
            for (int ai = 0; ai < 2; ++ai)
#pragma unroll
                for (int m = 0; m < 4; ++m) { f32x4 v0 = acc[ai][0][m][0], v1 = acc[ai][0][m][1]; const f32x4 g0 = acc[ai][1][m][0], g1 = acc[ai][1][m][1];
#pragma unroll
                    for (int j = 0; j < 4; ++j) { v0[j] *= sigmoidf_(g0[j]); v1[j] *= sigmoidf_(g1[j]); }
                    u32x4 w; w.x = cvtpk(v0[0], v0[1]); w.y = cvtpk(v0[2], v0[3]); w.z = cvtpk(v1[0], v1[1]); w.w = cvtpk(v1[2], v1[3]);
                    *(u32x4*)(U + (size_t)(row0 + ai * 128 + m * 16) * 1024 + col0) = w; }
        } else {
            const int col0 = (u.pn - 8) * 256 + wc * 32 + 8 * fq;
#pragma unroll
            for (int ai = 0; ai < 2; ++ai)
#pragma unroll
                for (int m = 0; m < 4; ++m)
#pragma unroll
                    for (int bj = 0; bj < 2; ++bj) { f32x4 v0 = acc[ai][bj][m][0], v1 = acc[ai][bj][m][1];
#pragma unroll
                        for (int j = 0; j < 4; ++j) { v0[j] = siluf_(v0[j]); v1[j] = siluf_(v1[j]); }
                        u32x4 w; w.x = cvtpk(v0[0], v0[1]); w.y = cvtpk(v0[2], v0[3]); w.z = cvtpk(v1[0], v1[1]); w.w = cvtpk(v1[2], v1[3]);
                        *(u32x4*)(SG + (size_t)(row0 + ai * 128 + m * 16) * 1024 + col0 + bj * 128) = w; }
        }
    }
};

namespace att {
constexpr float SCALE = 0.10206207261596577f;
constexpr float THR = 8.f;
constexpr int SHM_V = 64 * 64 * 2, SHM_K = 64 * 256;
#define KSWZ(row, colB) ((row) * 256 + ((colB) ^ (((row) & 7) << 4)))
#define SBAR() __builtin_amdgcn_sched_barrier(0)
__device__ __forceinline__ int crow(int r, int hi) { return (r & 3) + 8 * (r >> 2) + 4 * hi; }
__device__ __forceinline__ void partialSM(f32x16& p0, f32x16& p1, float& m_reg, float& mn, float& alpha) {
    constexpr float C = SCALE * 1.4426950408889634f;
    float pmax = p0[0];
#pragma unroll
    for (int r = 1; r < 16; ++r) pmax = fmaxf(pmax, p0[r]);
#pragma unroll
    for (int r = 0; r < 16; ++r) pmax = fmaxf(pmax, p1[r]);
    { auto rr = __builtin_amdgcn_permlane32_swap(__float_as_uint(pmax), __float_as_uint(pmax), false, false);
      pmax = fmaxf(__uint_as_float(rr[0]), __uint_as_float(rr[1])); }
    if (__builtin_expect(__all(pmax - m_reg <= THR / SCALE), 1)) { mn = m_reg; alpha = 1.f; }
    else { mn = fmaxf(m_reg, pmax); alpha = __builtin_amdgcn_exp2f((m_reg - mn) * C); m_reg = mn; }
    const float mnC = -mn * C;
#pragma unroll
    for (int r = 0; r < 16; ++r) p0[r] = fmaf(p0[r], C, mnC);
#pragma unroll
    for (int r = 0; r < 16; ++r) p1[r] = fmaf(p1[r], C, mnC);
#pragma unroll
    for (int r = 0; r < 16; ++r) p0[r] = __builtin_amdgcn_exp2f(p0[r]);
}
__device__ __forceinline__ void finishSM(f32x16& p0, f32x16& p1, float alpha, float& l_reg, bf16x8& pa0, bf16x8& pa1, bf16x8& pa2, bf16x8& pa3) {
#pragma unroll
    for (int r = 0; r < 16; ++r) p1[r] = __builtin_amdgcn_exp2f(p1[r]);
    float ps = 0;
#pragma unroll
    for (int r = 0; r < 16; ++r) ps += p0[r];
#pragma unroll
    for (int r = 0; r < 16; ++r) ps += p1[r];
    { auto rr = __builtin_amdgcn_permlane32_swap(__float_as_uint(ps), __float_as_uint(ps), false, false);
      ps = __uint_as_float(rr[0]) + __uint_as_float(rr[1]); }
    l_reg = l_reg * alpha + ps;
#define PK4(P, BASE, OUT) do { unsigned a0 = cvtpk(P[BASE + 0], P[BASE + 1]), a1 = cvtpk(P[BASE + 2], P[BASE + 3]);   \
    unsigned b0 = cvtpk(P[BASE + 4], P[BASE + 5]), b1 = cvtpk(P[BASE + 6], P[BASE + 7]);                              \
    auto r0 = __builtin_amdgcn_permlane32_swap(a0, b0, false, false); auto r1 = __builtin_amdgcn_permlane32_swap(a1, b1, false, false); \
    u32x4 w = {r0[0], r1[0], r0[1], r1[1]}; OUT = *reinterpret_cast<bf16x8*>(&w); } while (0)
    PK4(p0, 0, pa0); PK4(p0, 8, pa1); PK4(p1, 0, pa2); PK4(p1, 8, pa3);
#undef PK4
}
__device__ __forceinline__ void qkt(f32x16& p0, f32x16& p1, const char* Ks, const bf16x8* qr, int r32, int hi, bool active) {
    if (active) {
        p0 = f32x16{}; p1 = f32x16{};
#pragma unroll
        for (int d0 = 0; d0 < 6; ++d0) { const int cb = (d0 * 16 + hi * 8) * 2;
            const bf16x8 b0 = *reinterpret_cast<const bf16x8*>(Ks + KSWZ(r32, cb));
            const bf16x8 b1 = *reinterpret_cast<const bf16x8*>(Ks + KSWZ(32 + r32, cb));
            p0 = __builtin_amdgcn_mfma_f32_32x32x16_bf16(b0, qr[d0], p0, 0, 0, 0);
            p1 = __builtin_amdgcn_mfma_f32_32x32x16_bf16(b1, qr[d0], p1, 0, 0, 0); }
    } else {
#pragma unroll
        for (int r = 0; r < 16; ++r) { p0[r] = -1e30f; p1[r] = -1e30f; }
    }
}
__device__ __forceinline__ int v_st(int k, int c) { const int kk = (k & ~0xC) | ((k & 4) << 1) | ((k & 8) >> 1); return ((kk >> 3) * 2 + (c >> 5)) * 512 + ((kk & 7) * 32 + (c & 31)) * 2; }
__device__ __forceinline__ int v_rd_base(int lane) { return ((lane & 3) << 3) | (((lane >> 2) & 3) << 6) | (((lane >> 4) & 1) << 5) | (((lane >> 5) & 1) << 8); }
constexpr int v_rd_off(int d0, int ks, int half) { return d0 * 512 + ks * 2048 + half * 1024; }
template <int OFF> __device__ __forceinline__ s16x4 tr_read(int vb) {
    s16x4 r; asm volatile("ds_read_b64_tr_b16 %0, %1 offset:%2" : "=&v"(r) : "v"(vb), "i"(OFF) : "memory"); return r;
}
template <int D0> __device__ __forceinline__ void pv_one(f32x16& od, int vb, bf16x8 pa0, bf16x8 pa1, bf16x8 pa2, bf16x8 pa3) {
    const s16x4 l0 = tr_read<v_rd_off(D0, 0, 0)>(vb), h0 = tr_read<v_rd_off(D0, 0, 1)>(vb), l1 = tr_read<v_rd_off(D0, 1, 0)>(vb), h1 = tr_read<v_rd_off(D0, 1, 1)>(vb);
    const s16x4 l2 = tr_read<v_rd_off(D0, 2, 0)>(vb), h2 = tr_read<v_rd_off(D0, 2, 1)>(vb), l3 = tr_read<v_rd_off(D0, 3, 0)>(vb), h3 = tr_read<v_rd_off(D0, 3, 1)>(vb);
    asm volatile("s_waitcnt lgkmcnt(0)" ::: "memory"); SBAR();
#define PK(L, H) (bf16x8){L[0], L[1], L[2], L[3], H[0], H[1], H[2], H[3]}
    od = __builtin_amdgcn_mfma_f32_32x32x16_bf16(pa0, PK(l0, h0), od, 0, 0, 0);
    od = __builtin_amdgcn_mfma_f32_32x32x16_bf16(pa1, PK(l1, h1), od, 0, 0, 0);
    od = __builtin_amdgcn_mfma_f32_32x32x16_bf16(pa2, PK(l2, h2), od, 0, 0, 0);
    od = __builtin_amdgcn_mfma_f32_32x32x16_bf16(pa3, PK(l3, h3), od, 0, 0, 0);
#undef PK
}
__device__ __forceinline__ void pv_d0(f32x16* o, int vb, bf16x8 pa0, bf16x8 pa1, bf16x8 pa2, bf16x8 pa3) {
    pv_one<0>(o[0], vb, pa0, pa1, pa2, pa3); pv_one<1>(o[1], vb, pa0, pa1, pa2, pa3);
}

__device__ __forceinline__ void attn_unit(int b, int h, int qb, const bf16* __restrict__ Q, const bf16* __restrict__ KV, const bf16* __restrict__ KR,
                                          const bf16* __restrict__ Z, bf16* __restrict__ CAT, const float* __restrict__ cosT, const float* __restrict__ sinT, char* lds, int wave_s) {
    const int tid = opaque_tid(wave_s), wid = tid >> 6, lane = tid & 63, r32 = lane & 31, hi = lane >> 5;
    char* V_lds = lds; char* K_lds = lds + 2 * SHM_V;
    float* ws = (float*)(lds + 2 * SHM_V + 2 * SHM_K) + wid * 64; float* li_l = ws; float* al_l = ws + 32;
    float m_reg = -1e30f, l_reg = 0; f32x16 o[2] = {}; bf16x8 qr[6];
    const long rowbase = (long)b * SEQ; const int q0 = qb * 256;
    const bf16* Qw = Q + (rowbase + q0 + wid * 32 + r32) * 768 + h * 96 + hi * 8;
#pragma unroll
    for (int d0 = 0; d0 < 6; ++d0) qr[d0] = *reinterpret_cast<const bf16x8*>(Qw + d0 * 16);
    {
        const size_t qrow = (size_t)(rowbase + q0 + wid * 32 + r32);
        const f32x4 c0 = *(const f32x4*)(cosT + qrow * 16 + 8 * hi), c1 = *(const f32x4*)(cosT + qrow * 16 + 8 * hi + 4);
        const f32x4 s0 = *(const f32x4*)(sinT + qrow * 16 + 8 * hi), s1 = *(const f32x4*)(sinT + qrow * 16 + 8 * hi + 4);
        const u32x4 t1w = __builtin_bit_cast(u32x4, qr[4]), t2w = __builtin_bit_cast(u32x4, qr[5]); u32x4 o1, o2;
#pragma unroll
        for (int q = 0; q < 4; ++q) { const float cl = q < 2 ? c0[2 * q] : c1[2 * q - 4], ch = q < 2 ? c0[2 * q + 1] : c1[2 * q - 3];
            const float sl = q < 2 ? s0[2 * q] : s1[2 * q - 4], sh = q < 2 ? s0[2 * q + 1] : s1[2 * q - 3];
            const float a_lo = bflo(t1w[q]), a_hi = bfhi(t1w[q]), b_lo = bflo(t2w[q]), b_hi = bfhi(t2w[q]);
            o1[q] = cvtpk(a_lo * cl - b_lo * sl, a_hi * ch - b_hi * sh); o2[q] = cvtpk(b_lo * cl + a_lo * sl, b_hi * ch + a_hi * sh); }
        qr[4] = __builtin_bit_cast(bf16x8, o1); qr[5] = __builtin_bit_cast(bf16x8, o2);
    }
    const int sr = tid >> 3, sc = (tid & 7) * 8, sr2 = (tid & 255) >> 2, sc2 = (tid & 3) * 8;
    const int vst = v_st(sr, sc), kst = KSWZ(sr, sc * 2), kst2 = KSWZ(sr2, (64 + sc2) * 2);
    const bf16* kvsrc = KV + (rowbase + sr) * 1024 + h * 128 + sc;
    const bf16* krsrc = KR + (rowbase + sr2) * 32 + sc2;
    const int vb0 = (int)(uintptr_t)V_lds + v_rd_base(lane);
    struct { bf16x8 kn, vv, kr; } sr_[2];
#define SLOAD(i, k0) do { sr_[i].kn = *reinterpret_cast<const bf16x8*>(kvsrc + (long)(k0) * 1024); sr_[i].vv = *reinterpret_cast<const bf16x8*>(kvsrc + (long)(k0) * 1024 + 64); \
    sr_[i].kr = *reinterpret_cast<const bf16x8*>(krsrc + (long)(k0) * 32); } while (0)
#define SWRITE(bb, i) do { *(bf16x8*)(V_lds + (bb) * SHM_V + vst) = sr_[i].vv; *(bf16x8*)(K_lds + (bb) * SHM_K + kst) = sr_[i].kn; *(bf16x8*)(K_lds + (bb) * SHM_K + kst2) = sr_[i].kr; } while (0)
#define SWAIT() asm volatile("s_waitcnt vmcnt(3)" ::: "memory")
#define RESC(a) do { if (__any((a) < 1.f)) { if (hi == 0) al_l[r32] = (a); asm volatile("s_waitcnt lgkmcnt(0)" ::: "memory"); \
    _Pragma("unroll") for (int d = 0; d < 2; ++d) _Pragma("unroll") for (int r = 0; r < 16; ++r) o[d][r] *= al_l[crow(r, hi)]; } } while (0)
    f32x16 pA0, pA1, pB0, pB1; float mnA, mnB, alA, alB; bf16x8 pa0, pa1, pa2, pa3;
    const int NT = q0 / 64 + 4, jmax = q0 / 64 + (wid >> 1);
    SLOAD(0, 0); asm volatile("s_waitcnt vmcnt(0)" ::: "memory"); SWRITE(0, 0); __syncthreads();
    qkt(pA0, pA1, K_lds, qr, r32, hi, true); partialSM(pA0, pA1, m_reg, mnA, alA);
    SLOAD(1, 64); if (2 < NT) SLOAD(0, 128);
    SWAIT(); SWRITE(1, 1); __syncthreads();
    for (int j = 1; j + 1 < NT; j += 2) {
        SBAR(); qkt(pB0, pB1, K_lds + SHM_K, qr, r32, hi, j <= jmax);
        finishSM(pA0, pA1, alA, l_reg, pa0, pa1, pa2, pa3); SBAR();
        SLOAD(1, (j + 2) * 64); SBAR();
        pv_d0(o, vb0, pa0, pa1, pa2, pa3); partialSM(pB0, pB1, m_reg, mnB, alB);
        __syncthreads(); SWAIT(); SWRITE(0, 0);
        RESC(alB); __syncthreads();
        SBAR(); qkt(pA0, pA1, K_lds, qr, r32, hi, j + 1 <= jmax);
        finishSM(pB0, pB1, alB, l_reg, pa0, pa1, pa2, pa3); SBAR();
        if (j + 3 < NT) SLOAD(0, (j + 3) * 64); SBAR();
        pv_d0(o, vb0 + SHM_V, pa0, pa1, pa2, pa3); partialSM(pA0, pA1, m_reg, mnA, alA);
        __syncthreads(); SWAIT(); SWRITE(1, 1);
        RESC(alA); __syncthreads();
    }
    SBAR(); qkt(pB0, pB1, K_lds + SHM_K, qr, r32, hi, NT - 1 <= jmax);
    finishSM(pA0, pA1, alA, l_reg, pa0, pa1, pa2, pa3); SBAR();
    pv_d0(o, vb0, pa0, pa1, pa2, pa3); partialSM(pB0, pB1, m_reg, mnB, alB);
    __syncthreads(); RESC(alB);
    finishSM(pB0, pB1, alB, l_reg, pa0, pa1, pa2, pa3); SBAR();
    pv_d0(o, vb0 + SHM_V, pa0, pa1, pa2, pa3);
    if (hi == 0) li_l[r32] = l_reg; asm volatile("s_waitcnt lgkmcnt(0)" ::: "memory");
    float rli[16];
#pragma unroll
    for (int r = 0; r < 16; ++r) rli[r] = __builtin_amdgcn_rcpf(li_l[crow(r, hi)]);
    const long orow0 = rowbase + q0 + wid * 32;
#pragma unroll
    for (int r = 0; r < 16; ++r) { const long row = orow0 + crow(r, hi);
#pragma unroll
        for (int d0 = 0; d0 < 2; ++d0) { const float gz = bflo((unsigned)Z[row * ZLD + COL_BG + h * 64 + d0 * 32 + r32]);
            const float v = o[d0][r] * rli[r] * siluf_(gz);
            CAT[row * 1024 + 512 + h * 64 + d0 * 32 + r32] = (bf16)(cvtpk(v, v) & 0xffffu); } }
    __syncthreads();
#undef SLOAD
#undef SWRITE
#undef SWAIT
#undef RESC
}
#undef SBAR
}

struct Args {
    const float* x; const float* c; const int* pos; const float* ada_w; const float* ada_b; const float* pre_g; const float* post_g;
    const float* e_win; const float* e_scw; const float* e_scb; const float* e_qg; const float* e_kvg; const float* e_wuq; const float* e_wukv; const float* e_wout;
    const float* o_win; const float* o_cw; const float* o_cb; const float* o_lng; const float* o_lnb; const float* o_wout;
    float* out; unsigned char* ws; int ph_lo, ph_hi;
};

__device__ __forceinline__ void tr_item(const float* __restrict__ W, int N, const float* __restrict__ gk, bf16* __restrict__ WT, int ldt, int dst_row0, float* scr, int k0, int n0, int lane) {
#pragma unroll 8
    for (int i = 0; i < 32; ++i) { const int kk = 2 * i + (lane >> 5); float v = W[(size_t)(k0 + kk) * N + n0 + (lane & 31)]; if (gk) v *= gk[k0 + kk]; scr[kk * 33 + (lane & 31)] = v; }
    asm volatile("s_waitcnt lgkmcnt(0)" ::: "memory");
    const int c = lane & 7;
#pragma unroll
    for (int j = 0; j < 4; ++j) { const int n = (lane >> 3) + 8 * j; const float* s = scr + (8 * c) * 33 + n;
        u32x4 o; o.x = cvtpk(s[0 * 33], s[1 * 33]); o.y = cvtpk(s[2 * 33], s[3 * 33]); o.z = cvtpk(s[4 * 33], s[5 * 33]); o.w = cvtpk(s[6 * 33], s[7 * 33]);
        *(u32x4*)(WT + (size_t)(dst_row0 + n) * ldt + k0 + 8 * c) = o; }
    asm volatile("s_waitcnt lgkmcnt(0)" ::: "memory");
}

__device__ __forceinline__ void p0_phase(const Args& a, char* lds, int G, int wave_s) {
    const int tid = opaque_tid(wave_s), lane = tid & 63, wave = wave_s;
    unsigned char* ws = a.ws;
    {
        float* cact = (float*)lds; float* part = (float*)(lds + 16384); float* mod = (float*)(ws + WS_MOD);
        for (int task = blockIdx.x; task < 192; task += G) {
            const int l = task / 48, n0 = (task % 48) * 64;
            for (int i = tid; i < 4096; i += 512) { const float v = a.c[i]; cact[i] = siluf_(v); }
            __syncthreads();
            const float* W = a.ada_w + (size_t)l * 1024 * 3072 + n0 + lane; const int k0 = wave * 128;
            float a0 = 0.f, a1 = 0.f, a2 = 0.f, a3 = 0.f;
#pragma unroll 8
            for (int k = 0; k < 128; ++k) { const float w = W[(size_t)(k0 + k) * 3072]; a0 += cact[k0 + k] * w; a1 += cact[1024 + k0 + k] * w; a2 += cact[2048 + k0 + k] * w; a3 += cact[3072 + k0 + k] * w; }
            part[(wave * 4 + 0) * 64 + lane] = a0; part[(wave * 4 + 1) * 64 + lane] = a1; part[(wave * 4 + 2) * 64 + lane] = a2; part[(wave * 4 + 3) * 64 + lane] = a3;
            __syncthreads();
            if (tid < 256) { const int b = tid >> 6, j = tid & 63; float s = 0.f;
#pragma unroll
                for (int w = 0; w < 8; ++w) s += part[(w * 4 + b) * 64 + j];
                mod[(size_t)(l * 4 + b) * 3072 + n0 + j] = s + a.ada_b[l * 3072 + n0 + j]; }
            __syncthreads();
        }
    }
    {
        float* scr = (float*)(lds + wave * 16384);
        const int gw = blockIdx.x * 8 + wave, NGW = G * 8;
        constexpr int I_EW = 16 * 93, I_UQ = 4 * 24, I_UKV = 2 * 32, I_WO = 16 * 32, I_OW = 16 * 96;
        constexpr int NITEMS = 2 * (I_EW + I_UQ + I_UKV + I_WO + I_OW + I_WO);
        for (int it = gw; it < NITEMS; it += NGW) {
            int r = it;
            if (r < 2 * I_EW) { const int li = r / I_EW, rr = r % I_EW, kb = rr / 93, nb = rr % 93;
                tr_item(a.e_win + (size_t)li * 1024 * EVEN_IN, EVEN_IN, nullptr, (bf16*)(ws + WS_EWIN) + (size_t)li * 3072 * 1024, 1024, 32 * nb, scr, 64 * kb, 32 * nb, lane); continue; } r -= 2 * I_EW;
            if (r < 2 * I_OW) { const int li = r / I_OW, rr = r % I_OW, kb = rr / 96, nb = rr % 96; const int n0 = 32 * nb;
                int drow; if (n0 < 2048) { const int part = n0 >> 10, ch = n0 & 1023; drow = 256 * (ch >> 7) + 128 * part + (ch & 127); } else drow = n0;
                tr_item(a.o_win + (size_t)li * 1024 * 3072, 3072, nullptr, (bf16*)(ws + WS_OWIN) + (size_t)li * 3072 * 1024, 1024, drow, scr, 64 * kb, n0, lane); continue; } r -= 2 * I_OW;
            if (r < 2 * I_WO) { const int li = r / I_WO, rr = r % I_WO, kb = rr / 32, nb = rr % 32;
                tr_item(a.e_wout + (size_t)li * 1024 * 1024, 1024, nullptr, (bf16*)(ws + WS_EWOUT) + (size_t)li * 1024 * 1024, 1024, 32 * nb, scr, 64 * kb, 32 * nb, lane); continue; } r -= 2 * I_WO;
            if (r < 2 * I_WO) { const int li = r / I_WO, rr = r % I_WO, kb = rr / 32, nb = rr % 32;
                tr_item(a.o_wout + (size_t)li * 1024 * 1024, 1024, nullptr, (bf16*)(ws + WS_OWOUT) + (size_t)li * 1024 * 1024, 1024, 32 * nb, scr, 64 * kb, 32 * nb, lane); continue; } r -= 2 * I_WO;
            if (r < 2 * I_UQ) { const int li = r / I_UQ, rr = r % I_UQ, kb = rr / 24, nb = rr % 24;
                tr_item(a.e_wuq + (size_t)li * 256 * 768, 768, a.e_qg + li * 256, (bf16*)(ws + WS_WUQ) + (size_t)li * 768 * 256, 256, 32 * nb, scr, 64 * kb, 32 * nb, lane); continue; } r -= 2 * I_UQ;
            { const int li = r / I_UKV, rr = r % I_UKV, kb = rr / 32, nb = rr % 32;
                tr_item(a.e_wukv + (size_t)li * 128 * 1024, 1024, a.e_kvg + li * 128, (bf16*)(ws + WS_WUKV) + (size_t)li * 1024 * 128, 128, 32 * nb, scr, 64 * kb, 32 * nb, lane); }
        }
    }
    {
        const int gt = blockIdx.x * 512 + tid, NGT = G * 512;
        for (int e = gt; e < 2 * 96 * 128; e += NGT) { const int li = e / (96 * 128), rr = e % (96 * 128);
            *(u32x4*)((bf16*)(ws + WS_EWIN) + (size_t)li * 3072 * 1024 + (size_t)EVEN_IN * 1024 + (size_t)rr * 8) = (u32x4){0u, 0u, 0u, 0u}; }
        float* cosT = (float*)(ws + WS_COS); float* sinT = (float*)(ws + WS_SIN);
        for (int e = gt; e < M * 16; e += NGT) { const int m = e >> 4, i = e & 15;
            const float inv_freq = 1.0f / powf(10000.0f, (float)(2 * i) * (1.0f / 32.0f));
            const float x = (float)a.pos[m] * inv_freq;
            const float n = rintf(x * 0.15915494309189535f);
            float r = fmaf(-n, 6.28125f, x); r = fmaf(-n, 1.9353071795864769e-3f, r);
            cosT[e] = cosf(r); sinT[e] = sinf(r); }
    }
}

template <bool HAS_POST, bool HAS_PRE>
__device__ __forceinline__ void norm_phase(const float* __restrict__ xin, float* __restrict__ xout, bf16* Hb, const float* mod_prev, const float* postg, const float* mod_next, const float* preg,
                                           int G, int wave_s) {
    const int tid = opaque_tid(wave_s), lane = tid & 63, wave = wave_s;
    const int gw = blockIdx.x * 8 + wave, NGW = G * 8;
    for (int ch = gw; ch < M / 8; ch += NGW) {
        const int row0 = ch * 8, b = row0 / SEQ;
        f32x4 GA[4], PB[4], SH[4];
#pragma unroll
        for (int j = 0; j < 4; ++j) { const int c = 4 * lane + 256 * j;
            if (HAS_POST) { GA[j] = *(const f32x4*)(mod_prev + (size_t)b * 3072 + 2048 + c) * *(const f32x4*)(postg + c); }
            if (HAS_PRE) { PB[j] = *(const f32x4*)(preg + c) * (*(const f32x4*)(mod_next + (size_t)b * 3072 + 1024 + c) + 1.0f); SH[j] = *(const f32x4*)(mod_next + (size_t)b * 3072 + c); } }
#pragma unroll 2
        for (int rr = 0; rr < 8; ++rr) { const size_t row = row0 + rr;
            f32x4 xv[4];
#pragma unroll
            for (int j = 0; j < 4; ++j) xv[j] = *(const f32x4*)(xin + row * DM + 4 * lane + 256 * j);
            if (HAS_POST) {
                f32x4 yv[4]; float s = 0.f;
#pragma unroll
                for (int j = 0; j < 4; ++j) { const u32x2 w = *(const u32x2*)(Hb + row * DM + 4 * lane + 256 * j); yv[j] = (f32x4){bflo(w.x), bfhi(w.x), bflo(w.y), bfhi(w.y)};
                    s += (yv[j][0] * yv[j][0] + yv[j][1] * yv[j][1]) + (yv[j][2] * yv[j][2] + yv[j][3] * yv[j][3]); }
                const float rstd = rsqrtf(wave_sum(s) * (1.f / DM) + EPS);
#pragma unroll
                for (int j = 0; j < 4; ++j) { xv[j] = xv[j] + GA[j] * (yv[j] * rstd); *(f32x4*)(xout + row * DM + 4 * lane + 256 * j) = xv[j]; }
            }
            if (HAS_PRE) {
                float s = 0.f;
#pragma unroll
                for (int j = 0; j < 4; ++j) s += (xv[j][0] * xv[j][0] + xv[j][1] * xv[j][1]) + (xv[j][2] * xv[j][2] + xv[j][3] * xv[j][3]);
                const float rstd = rsqrtf(wave_sum(s) * (1.f / DM) + EPS);
#pragma unroll
                for (int j = 0; j < 4; ++j) { const f32x4 hv = (xv[j] * rstd) * PB[j] + SH[j]; u32x2 w; w.x = cvtpk(hv[0], hv[1]); w.y = cvtpk(hv[2], hv[3]);
                    *(u32x2*)(Hb + row * DM + 4 * lane + 256 * j) = w; }
            }
        }
    }
}

__device__ __forceinline__ void ew_even_phase(const bf16* __restrict__ Z, bf16* __restrict__ CAT, bf16* __restrict__ KR, const float* __restrict__ scw, const float* __restrict__ scb,
                                              const float* __restrict__ cosT, const float* __restrict__ sinT, int G, int wave_s) {
    const int tid = opaque_tid(wave_s), lane = tid & 63, wave = wave_s;
    const int gw = blockIdx.x * 8 + wave, NGW = G * 8;
    const int c0 = 8 * lane;
    float w0[8], w1[8], w2[8], bb[8];
#pragma unroll
    for (int j = 0; j < 8; ++j) { w0[j] = scw[c0 + j]; w1[j] = scw[512 + c0 + j]; w2[j] = scw[1024 + c0 + j]; bb[j] = scb[c0 + j]; }
    for (int ch = gw; ch < M / 8; ch += NGW) {
        const int row0 = ch * 8, s0 = row0 % SEQ;
        float pm2[8], pm1[8];
        if (s0 == 0) {
#pragma unroll
            for (int j = 0; j < 8; ++j) { pm2[j] = 0.f; pm1[j] = 0.f; }
        } else {
            const u32x4 c2 = *(const u32x4*)(Z + (size_t)(row0 - 2) * ZLD + 512 + c0), x2 = *(const u32x4*)(Z + (size_t)(row0 - 2) * ZLD + 1024 + c0);
            const u32x4 c1 = *(const u32x4*)(Z + (size_t)(row0 - 1) * ZLD + 512 + c0), x1 = *(const u32x4*)(Z + (size_t)(row0 - 1) * ZLD + 1024 + c0);
#pragma unroll
            for (int q = 0; q < 4; ++q) { pm2[2 * q] = bflo(c2[q]) * bflo(x2[q]); pm2[2 * q + 1] = bfhi(c2[q]) * bfhi(x2[q]); pm1[2 * q] = bflo(c1[q]) * bflo(x1[q]); pm1[2 * q + 1] = bfhi(c1[q]) * bfhi(x1[q]); }
        }
#pragma unroll 2
        for (int rr = 0; rr < 8; ++rr) { const size_t row = row0 + rr; const bf16* zr = Z + row * ZLD;
            const u32x4 vb = *(const u32x4*)(zr + c0), vc = *(const u32x4*)(zr + 512 + c0), vx = *(const u32x4*)(zr + 1024 + c0), vg = *(const u32x4*)(zr + 1536 + c0);
            float p[8], ab[8], ag[8];
#pragma unroll
            for (int q = 0; q < 4; ++q) { p[2 * q] = bflo(vc[q]) * bflo(vx[q]); p[2 * q + 1] = bfhi(vc[q]) * bfhi(vx[q]); ab[2 * q] = bflo(vb[q]); ab[2 * q + 1] = bfhi(vb[q]); ag[2 * q] = bflo(vg[q]); ag[2 * q + 1] = bfhi(vg[q]); }
            float o[8];
#pragma unroll
            for (int j = 0; j < 8; ++j) { const float cv = w0[j] * pm2[j] + w1[j] * pm1[j] + w2[j] * p[j] + bb[j]; o[j] = ab[j] * cv * siluf_(ag[j]); pm2[j] = pm1[j]; pm1[j] = p[j]; }
            u32x4 w; w.x = cvtpk(o[0], o[1]); w.y = cvtpk(o[2], o[3]); w.z = cvtpk(o[4], o[5]); w.w = cvtpk(o[6], o[7]);
            *(u32x4*)(CAT + row * 1024 + c0) = w;
            if (lane < 16) { const float t1 = bflo((unsigned)zr[COL_KR + lane]), t2 = bflo((unsigned)zr[COL_KR + 16 + lane]); const float cs = cosT[row * 16 + lane], sn = sinT[row * 16 + lane];
                const float o1 = t1 * cs - t2 * sn, o2 = t2 * cs + t1 * sn;
                KR[row * 32 + lane] = (bf16)(cvtpk(o1, o1) & 0xffffu); KR[row * 32 + 16 + lane] = (bf16)(cvtpk(o2, o2) & 0xffffu); }
        }
    }
}

__device__ __forceinline__ void conv_odd_phase(const bf16* __restrict__ U, const bf16* __restrict__ SG, bf16* __restrict__ A2, const float* __restrict__ cw, const float* __restrict__ cb,
                                               const float* __restrict__ lng, const float* __restrict__ lnb, char* lds, int G, int wave_s) {
    const int tid = opaque_tid(wave_s), lane = tid & 63, wave = wave_s;
    typedef float f32x2 __attribute__((ext_vector_type(2)));
    float* cbuf = (float*)lds;
    f32x2 w[31];
#pragma unroll
    for (int k = 0; k < 31; ++k) w[k] = *(const f32x2*)(cw + k * 1024 + 2 * tid);
    const f32x2 bias = *(const f32x2*)(cb + 2 * tid);
    f32x4 lg[4], lb[4];
#pragma unroll
    for (int j = 0; j < 4; ++j) { lg[j] = *(const f32x4*)(lng + 4 * lane + 256 * j); lb[j] = *(const f32x4*)(lnb + 4 * lane + 256 * j); }
    for (int run = blockIdx.x; run < M / 64; run += G) {
        const int tr = run * 64; const bool halo = (tr % SEQ) != 0;
        const bf16* Ub = U + (size_t)tr * 1024 + 2 * tid;
        unsigned uv[46];
#pragma unroll
        for (int i = 0; i < 30; ++i) uv[i] = halo ? *(const unsigned*)(Ub + (long)(i - 30) * 1024) : 0u;
#pragma unroll
        for (int i = 0; i < 16; ++i) uv[30 + i] = *(const unsigned*)(Ub + (long)i * 1024);
#pragma unroll 1
        for (int c = 0; c < 4; ++c) {
            const int t0 = tr + 16 * c; float* cb_ = cbuf + (c & 1) * 16384;
            unsigned nu[16];
            if (c < 3) {
#pragma unroll
                for (int i = 0; i < 16; ++i) nu[i] = *(const unsigned*)(Ub + (long)(16 * (c + 1) + i) * 1024);
            } else {
#pragma unroll
                for (int i = 0; i < 16; ++i) nu[i] = 0u;
            }
            f32x2 acc[16];
#pragma unroll
            for (int j = 0; j < 16; ++j) acc[j] = bias;
#pragma unroll
            for (int i = 0; i < 46; ++i) {
                const f32x2 v = (f32x2){bflo(uv[i]), bfhi(uv[i])};
#pragma unroll
                for (int j = 0; j < 16; ++j) { const int k = i - j; if (k >= 0 && k <= 30) acc[j] += w[k] * v; }
            }
#pragma unroll
            for (int j = 0; j < 16; ++j) *(f32x2*)(cb_ + j * 1024 + 2 * tid) = acc[j];
            __syncthreads();
#pragma unroll
            for (int jj = 0; jj < 2; ++jj) { const int j = 2 * wave + jj; const size_t row = t0 + j;
                f32x4 v[4]; float s = 0.f;
#pragma unroll
                for (int q = 0; q < 4; ++q) { v[q] = *(const f32x4*)(cb_ + j * 1024 + 4 * lane + 256 * q); s += (v[q][0] + v[q][1]) + (v[q][2] + v[q][3]); }
                const float mean = wave_sum(s) * (1.f / 1024.f); float s2 = 0.f;
#pragma unroll
                for (int q = 0; q < 4; ++q) { v[q] = v[q] - mean; s2 += (v[q][0] * v[q][0] + v[q][1] * v[q][1]) + (v[q][2] * v[q][2] + v[q][3] * v[q][3]); }
                const float rstd = rsqrtf(wave_sum(s2) * (1.f / 1024.f) + EPS);
#pragma unroll
                for (int q = 0; q < 4; ++q) { const u32x2 gw_ = *(const u32x2*)(SG + row * 1024 + 4 * lane + 256 * q);
                    f32x4 y = (v[q] * rstd) * lg[q] + lb[q];
                    const f32x4 sg = (f32x4){bflo(gw_.x), bfhi(gw_.x), bflo(gw_.y), bfhi(gw_.y)};
#pragma unroll
                    for (int e = 0; e < 4; ++e) y[e] = siluf_(y[e]) * sg[e];
                    u32x2 ow; ow.x = cvtpk(y[0], y[1]); ow.y = cvtpk(y[2], y[3]);
                    *(u32x2*)(A2 + row * 1024 + 4 * lane + 256 * q) = ow; }
            }
#pragma unroll
            for (int i = 0; i < 30; ++i) uv[i] = uv[i + 16];
#pragma unroll
            for (int i = 0; i < 16; ++i) uv[30 + i] = nu[i];
        }
        __syncthreads();
    }
}

__global__ void __launch_bounds__(512, 2) mk_fwd(Args a) {
    extern __shared__ __attribute__((aligned(16))) unsigned char lds[];
    cg::grid_group grid = cg::this_grid();
    const int G = gridDim.x;
    const int wave_s = __builtin_amdgcn_readfirstlane((int)threadIdx.x >> 6);
    const int vcu = (G % 8 == 0) ? ((int)blockIdx.x % 8) * (G / 8) + (int)blockIdx.x / 8 : (int)blockIdx.x;
    unsigned char* ws = a.ws;
    float* mod = (float*)(ws + WS_MOD); float* ssq_q = (float*)(ws + WS_SSQ_Q); float* ssq_kv = (float*)(ws + WS_SSQ_KV);
    float* cosT = (float*)(ws + WS_COS); float* sinT = (float*)(ws + WS_SIN);
    bf16* KR = (bf16*)(ws + WS_KR); bf16* Hb = (bf16*)(ws + WS_H); bf16* Zb = (bf16*)(ws + WS_Z); bf16* KVb = (bf16*)(ws + WS_KV); bf16* CAT = (bf16*)(ws + WS_CAT);
    PG8_LAS unsigned char* ldsL = (PG8_LAS unsigned char*)lds;
    volatile LAS unsigned* bst = (volatile LAS unsigned*)(ldsL + 131072 + 64);
    if (threadIdx.x < 2) bst[threadIdx.x] = 0u;
    __syncthreads();
    XcdBarrier xbar = xcd_barrier_post((unsigned*)ws, bst);
    int ph = 0; const int lo = a.ph_lo, hi = a.ph_hi;
#define PH_BEGIN(REP) if (ph >= lo && ph < hi) { _Pragma("unroll") for (int rep_ = 0; rep_ < (REP); ++rep_) {
#define PH_END } } ++ph; if (ph > lo && ph < hi) { _Pragma("unroll") for (int rs_ = 0; rs_ < REP_SYNC; ++rs_) { if (ph == 1) grid.sync(); else xcd_barrier(xbar); } }

    PH_BEGIN(REP_P0) p0_phase(a, (char*)lds, G, wave_s); PH_END
    PH_BEGIN(REP_NORM0) norm_phase<false, true>(a.x, nullptr, Hb, nullptr, nullptr, mod, a.pre_g, G, wave_s); PH_END

#define LAYER_BODY(layer) do { \
        const int li = layer >> 1; \
        if ((layer & 1) == 0) { \
            PH_BEGIN(REP_GIN) \
                pg8::Gemm g{Hb, 1024, (const bf16*)(ws + WS_EWIN) + (size_t)li * 3072 * 1024, 1024, M, 3072, 1024, wave_s}; pg8::StaticOrder S; S.init(M, 3072, G, (int)blockIdx.x); \
                EpiEvenIn E{Zb, ssq_q, ssq_kv}; \
                pg8::gemm_phase<EpiEvenIn, pg8::StaticOrder, true, true>(ldsL, g, S, E); \
            PH_END \
            PH_BEGIN(REP_E2) \
                { pg8::Gemm g{Zb + COL_CQ, ZLD, (const bf16*)(ws + WS_WUQ) + (size_t)li * 768 * 256, 256, M, 768, 256, wave_s}; pg8::StaticOrder S; S.init(M, 768, G, (int)blockIdx.x); \
                  EpiQ E{Hb, ssq_q}; \
                  pg8::gemm_phase<EpiQ, pg8::StaticOrder, true, true>(ldsL, g, S, E); } \
                { pg8::Gemm g{Zb + COL_CKV, ZLD, (const bf16*)(ws + WS_WUKV) + (size_t)li * 1024 * 128, 128, M, 1024, 128, wave_s}; pg8::StaticOrder S; S.init(M, 1024, G, (int)blockIdx.x); \
                  EpiKV E{KVb, ssq_kv}; \
                  pg8::gemm_phase<EpiKV, pg8::StaticOrder, true, true>(ldsL, g, S, E); } \
                ew_even_phase(Zb, CAT, KR, a.e_scw + li * 3 * 512, a.e_scb + li * 512, cosT, sinT, G, wave_s); \
            PH_END \
            PH_BEGIN(REP_ATT) \
                for (int pi = vcu; pi < 256; pi += G) { const int bh = pi >> 3, s = pi & 7; \
                    att::attn_unit(bh >> 3, bh & 7, 15 - s, Hb, KVb, KR, Zb, CAT, cosT, sinT, (char*)lds, wave_s); \
                    att::attn_unit(bh >> 3, bh & 7, s, Hb, KVb, KR, Zb, CAT, cosT, sinT, (char*)lds, wave_s); } \
            PH_END \
            PH_BEGIN(REP_GOUT) \
                pg8::Gemm g{CAT, 1024, (const bf16*)(ws + WS_EWOUT) + (size_t)li * 1024 * 1024, 1024, M, 1024, 1024, wave_s}; pg8::StaticOrder S; S.init(M, 1024, G, (int)blockIdx.x); \
                EpiPlain E{Hb, 1024}; \
                pg8::gemm_phase<EpiPlain, pg8::StaticOrder, true, true>(ldsL, g, S, E); \
            PH_END \
        } else { \
            PH_BEGIN(REP_GIN) \
                pg8::Gemm g{Hb, 1024, (const bf16*)(ws + WS_OWIN) + (size_t)li * 3072 * 1024, 1024, M, 3072, 1024, wave_s}; pg8::StaticOrder S; S.init(M, 3072, G, (int)blockIdx.x); \
                EpiOddIn E{Zb, Zb + (size_t)M * 1024}; \
                pg8::gemm_phase<EpiOddIn, pg8::StaticOrder, true, true>(ldsL, g, S, E); \
            PH_END \
            PH_BEGIN(REP_CONV) \
                conv_odd_phase(Zb, Zb + (size_t)M * 1024, CAT, a.o_cw + li * 31 * 1024, a.o_cb + li * 1024, a.o_lng + li * 1024, a.o_lnb + li * 1024, (char*)lds, G, wave_s); \
            PH_END \
            PH_BEGIN(REP_GOUT) \
                pg8::Gemm g{CAT, 1024, (const bf16*)(ws + WS_OWOUT) + (size_t)li * 1024 * 1024, 1024, M, 1024, 1024, wave_s}; pg8::StaticOrder S; S.init(M, 1024, G, (int)blockIdx.x); \
                EpiPlain E{Hb, 1024}; \
                pg8::gemm_phase<EpiPlain, pg8::StaticOrder, true, true>(ldsL, g, S, E); \
            PH_END \
        } \
        PH_BEGIN(1) \
            const float* xin = (layer == 0) ? a.x : a.out; \
            if (layer < 3) norm_phase<true, true>(xin, a.out, Hb, mod + (size_t)layer * 4 * 3072, a.post_g + layer * 1024, mod + (size_t)(layer + 1) * 4 * 3072, a.pre_g + (layer + 1) * 1024, G, wave_s); \
            else norm_phase<true, false>(xin, a.out, Hb, mod + (size_t)layer * 4 * 3072, a.post_g + layer * 1024, nullptr, nullptr, G, wave_s); \
        PH_END \
    } while (0)
    LAYER_BODY(0); LAYER_BODY(1); LAYER_BODY(2); LAYER_BODY(3);
#undef LAYER_BODY
#undef PH_BEGIN
#undef PH_END
}

constexpr int N_PHASES = 2 + 5 + 4 + 5 + 4;

extern "C" void kernel_launch(void* const* d_in, const int* in_sizes, int n_in, void* d_out, int out_size, void* d_ws, size_t ws_size, hipStream_t stream) {
    static int grid = 0;
    if (grid == 0) {
        if (n_in != 21 || in_sizes[0] != M * DM || out_size != M * DM || ws_size < WS_END) { fprintf(stderr, "kernel_launch: unexpected shapes (n_in %d, ws %zu)\n", n_in, ws_size); grid = -1; return; }
        int dev = 0, cus = 0, per_cu = 0;
        hipGetDevice(&dev); hipDeviceGetAttribute(&cus, hipDeviceAttributeMultiprocessorCount, dev);
        if (hipFuncSetAttribute((const void*)mk_fwd, hipFuncAttributeMaxDynamicSharedMemorySize, LDS_BYTES) != hipSuccess) { fprintf(stderr, "kernel_launch: hipFuncSetAttribute failed\n"); grid = -1; return; }
        if (hipOccupancyMaxActiveBlocksPerMultiprocessor(&per_cu, (const void*)mk_fwd, 512, LDS_BYTES) != hipSuccess || per_cu < 1) { fprintf(stderr, "kernel_launch: occupancy query says %d\n", per_cu); per_cu = 1; }
        (void)hipGetLastError();
        grid = cus;
        fprintf(stderr, "kernel_launch: cus %d per_cu %d grid %d\n", cus, per_cu, grid);
    }
    if (grid < 0) return;
    Args a{};
    a.x = (const float*)d_in[0]; a.c = (const float*)d_in[1]; a.pos = (const int*)d_in[2]; a.ada_w = (const float*)d_in[3]; a.ada_b = (const float*)d_in[4];
    a.pre_g = (const float*)d_in[5]; a.post_g = (const float*)d_in[6]; a.e_win = (const float*)d_in[7]; a.e_scw = (const float*)d_in[8]; a.e_scb = (const float*)d_in[9];
    a.e_qg = (const float*)d_in[10]; a.e_kvg = (const float*)d_in[11]; a.e_wuq = (const float*)d_in[12]; a.e_wukv = (const float*)d_in[13]; a.e_wout = (const float*)d_in[14];
    a.o_win = (const float*)d_in[15]; a.o_cw = (const float*)d_in[16]; a.o_cb = (const float*)d_in[17]; a.o_lng = (const float*)d_in[18]; a.o_lnb = (const float*)d_in[19]; a.o_wout = (const float*)d_in[20];
    a.out = (float*)d_out; a.ws = (unsigned char*)d_ws;
#if MK_ONE_LAUNCH
    if (hipMemsetAsync(d_ws, 0, 16384, stream) != hipSuccess) { fprintf(stderr, "kernel_launch: memset failed\n"); return; }
    a.ph_lo = 0; a.ph_hi = N_PHASES;
    void* args[] = {&a};
    hipError_t e = hipLaunchCooperativeKernel((const void*)mk_fwd, dim3(grid), dim3(512), args, LDS_BYTES, stream);
    if (e != hipSuccess) fprintf(stderr, "kernel_launch: cooperative launch failed: %s (grid %d)\n", hipGetErrorString(e), grid);
#else
    for (int p = 0; p < N_PHASES; ++p) { a.ph_lo = p; a.ph_hi = p + 1; hipLaunchKernelGGL(mk_fwd, dim3(grid), dim3(512), LDS_BYTES, stream, a); }
#endif
}
```
